# Optimizing an MI355X kernel written in HIP

```python
import jax, jax.numpy as jnp
from jax import lax
import numpy as np

D_MODEL = 1024
BATCH = 8
SEQ = 4096
DEPTH = 1

PLE_DIM = 256
D_FF = 2816
D_MIX = D_MODEL
CHUNK = 128
GM_HEADS = 4
GM_HEAD_DIM = 128
GM_WIDTH = GM_HEADS * GM_HEAD_DIM
SB_HEADS = 8
SB_HEAD_DIM = 64
SB_WIDTH = SB_HEADS * SB_HEAD_DIM
SB_BLOCK = 128
MIX_IN_WIDTH = 2 * GM_WIDTH + 3 * SB_WIDTH
EPS = 1e-6

kernel_name = "hybrid_gmlp_stickbreaking_macaron_block"


def rms_norm(x, g):
    xf = x.astype(jnp.float32)
    y = xf * lax.rsqrt(jnp.mean(xf * xf, axis=-1, keepdims=True) + EPS)
    return (y * g.astype(jnp.float32)).astype(x.dtype)


def swiglu(x, w_in, w_out):
    gate, up = jnp.split(x @ w_in, 2, axis=-1)
    return (jax.nn.silu(gate) * up) @ w_out


def chunked_gmlp(u, v, v_gain, w_s, b_s):
    B, S, _ = u.shape
    nc = S // CHUNK
    vn = rms_norm(v, v_gain).reshape(B, nc, CHUNK, GM_HEADS, GM_HEAD_DIM)
    causal = jnp.tril(jnp.ones((CHUNK, CHUNK), dtype=bool))
    w = jnp.where(causal[None], w_s, jnp.zeros_like(w_s)).astype(vn.dtype)
    sv = jnp.einsum('hts,bcshd->bcthd', w, vn) + b_s.T.astype(vn.dtype)[None, None, :, :, None]
    return u * sv.reshape(B, S, GM_WIDTH)


def stick_breaking_attention(q, k, v):
    B, S, H, D = q.shape
    scale = D ** -0.5
    outs = []
    for i in range(S // SB_BLOCK):
        q0 = i * SB_BLOCK
        L = q0 + SB_BLOCK
        qb = q[:, q0:L]
        kp = k[:, :L]
        vp = v[:, :L]
        z = jnp.einsum('bthd,bshd->bhts', qb, kp).astype(jnp.float32) * scale
        t_idx = q0 + jnp.arange(SB_BLOCK)[:, None]
        s_idx = jnp.arange(L)[None, :]
        causal = s_idx < t_idx
        log_1m = jnp.where(causal, -jax.nn.softplus(z), 0.0)
        after = lax.cumsum(log_1m, axis=3, reverse=True) - log_1m
        a = jnp.where(causal, jnp.exp(jax.nn.log_sigmoid(z) + after), 0.0)
        outs.append(jnp.einsum('bhts,bshd->bthd', a.astype(vp.dtype), vp))
    return jnp.concatenate(outs, axis=1)


def setup_inputs(seed: int = 0) -> dict:
    key = jax.random.key(seed)
    ks = jax.random.split(key, 18)
    f32 = jnp.float32

    def nrm(k, shape, fan_in):
        return jax.random.normal(k, shape, f32) * (fan_in ** -0.5)

    def gain(k, shape):
        return jnp.ones(shape, f32) + 0.05 * jax.random.normal(k, shape, f32)

    return {
        "x": jax.random.normal(ks[0], (BATCH, SEQ, D_MODEL), f32),
        "p": jax.random.normal(ks[1], (DEPTH, BATCH, SEQ, PLE_DIM), f32),
        "ffn1_norm": gain(ks[2], (DEPTH, D_MODEL)),
        "ffn1_w_in": nrm(ks[3], (DEPTH, D_MODEL, 2 * D_FF), D_MODEL),
        "ffn1_w_out": nrm(ks[4], (DEPTH, D_FF, D_MODEL), D_FF),
        "mix_norm": gain(ks[5], (DEPTH, D_MODEL)),
        "w_mix_in": nrm(ks[6], (DEPTH, D_MODEL, MIX_IN_WIDTH), D_MODEL),
        "gmlp_v_norm": gain(ks[7], (DEPTH, GM_WIDTH)),
        "gmlp_w_s": nrm(ks[8], (DEPTH, GM_HEADS, CHUNK, CHUNK), CHUNK),
        "gmlp_b": jnp.ones((DEPTH, GM_HEADS, CHUNK), f32) + 0.1 * jax.random.normal(ks[9], (DEPTH, GM_HEADS, CHUNK), f32),
        "w_mix_out": nrm(ks[10], (DEPTH, D_MIX, D_MODEL), D_MIX),
        "ffn2_norm": gain(ks[11], (DEPTH, D_MODEL)),
        "ffn2_w_in": nrm(ks[12], (DEPTH, D_MODEL, 2 * D_FF), D_MODEL),
        "ffn2_w_out": nrm(ks[13], (DEPTH, D_FF, D_MODEL), D_FF),
        "ple_norm": gain(ks[14], (DEPTH, D_MODEL)),
        "ple_w_gate": nrm(ks[15], (DEPTH, D_MODEL, D_MODEL), D_MODEL),
        "ple_w_proj": nrm(ks[16], (DEPTH, PLE_DIM, D_MODEL), PLE_DIM),
        "final_norm": gain(ks[17], (D_MODEL,)),
    }


def reference(x, p, ffn1_norm, ffn1_w_in, ffn1_w_out, mix_norm, w_mix_in, gmlp_v_norm,
              gmlp_w_s, gmlp_b, w_mix_out, ffn2_norm, ffn2_w_in, ffn2_w_out,
              ple_norm, ple_w_gate, ple_w_proj, final_norm):
    B, S, _ = x.shape
    splits = [GM_WIDTH, 2 * GM_WIDTH, 2 * GM_WIDTH + SB_WIDTH, 2 * GM_WIDTH + 2 * SB_WIDTH]
    h = x
    for i in range(DEPTH):
        h = h + 0.5 * swiglu(rms_norm(h, ffn1_norm[i]), ffn1_w_in[i], ffn1_w_out[i])

        n = rms_norm(h, mix_norm[i])
        zmix = n @ w_mix_in[i]
        gm_u, gm_v, sb_q, sb_k, sb_v = jnp.split(zmix, splits, axis=-1)
        gm_out = chunked_gmlp(jax.nn.gelu(gm_u, approximate=False),
                              jax.nn.gelu(gm_v, approximate=False),
                              gmlp_v_norm[i], gmlp_w_s[i], gmlp_b[i])
        sb_out = stick_breaking_attention(sb_q.reshape(B, S, SB_HEADS, SB_HEAD_DIM),
                                          sb_k.reshape(B, S, SB_HEADS, SB_HEAD_DIM),
                                          sb_v.reshape(B, S, SB_HEADS, SB_HEAD_DIM))
        mixed = jnp.concatenate([gm_out, sb_out.reshape(B, S, SB_WIDTH)], axis=-1)
        h = h + mixed @ w_mix_out[i]

        h = h + 0.5 * swiglu(rms_norm(h, ffn2_norm[i]), ffn2_w_in[i], ffn2_w_out[i])

        gate = jax.nn.sigmoid(rms_norm(h, ple_norm[i]) @ ple_w_gate[i])
        h = h + gate * (p[i] @ ple_w_proj[i])
    return rms_norm(h, final_norm)
```

```cpp
#include <hip/hip_runtime.h>
#include <cstdio>
#include <cstdint>
#define MK_N_LAUNCHES 1
namespace pg8 {
#define PG8_LAS __attribute__((address_space(3)))
typedef unsigned short bf16_t;
typedef short bf16x8 __attribute__((ext_vector_type(8)));
typedef float f32x4 __attribute__((ext_vector_type(4)));
typedef unsigned u32x4 __attribute__((ext_vector_type(4)));
constexpr int BM = 256, BK = 64, HALF = 128, HTB = HALF * BK * 2  , STAGE_BYTES = 8 * HTB, NXCD = 8, WGM = 8;

__host__ __device__ __forceinline__ int lds_byte(int r, int c) { const int st = (r >> 4) * 2 + (c >> 5), rr = r & 15, cc = c & 31, ob = rr * 64 + cc * 2; return st * 1024 + (ob ^ (((ob >> 9) & 1) << 5)); }
__host__ __device__ __forceinline__ void stage_rc(int b, int& R, int& C) { const int st = b / 1024, sb = b % 1024, swz = sb ^ (((sb >> 9) & 1) << 5); R = (st >> 1) * 16 + swz / 64; C = (st & 1) * 32 + (swz % 64) / 2; }
__host__ __device__ __forceinline__ int perm32(int rho) { const int n = rho >> 4, i = rho & 15; return 8 * (i >> 2) + 4 * n + (i & 3); }

struct Unit { int pm, pn; };
struct Gemm { const bf16_t* A; const bf16_t* Bt; int M, N, K; };

struct StaticOrder {
    int nM, nN, nwg, G, c;
    __host__ __device__ void init(int M, int N, int G_, int c_) { nM = M / BM; nN = N / BM; nwg = nM * nN; G = G_; c = c_; }
    __host__ __device__ bool next(int i, Unit& u) const {
        const long L = (long)i * G + c; if (L >= nwg) return false;
        int wgid = (int)L; { const int q = nwg / NXCD, r = nwg % NXCD, xcd = wgid % NXCD, off = wgid / NXCD; wgid = (xcd < r ? xcd * (q + 1) : r * (q + 1) + (xcd - r) * q) + off; }
        const int nig = WGM * nN, gid = wgid / nig, fm = gid * WGM, gsz = (nM - fm) < WGM ? (nM - fm) : WGM;
        u.pm = fm + ((wgid % nig) % gsz); u.pn = (wgid % nig) / gsz; return true;
    }
    __device__ __forceinline__ void a_ready(const Unit&) const {}
    __device__ __forceinline__ void done(const Unit&) const {}
};

__device__ __forceinline__ unsigned cvt_pk_bf16(float lo, float hi) { unsigned r; asm volatile("v_cvt_pk_bf16_f32 %0, %1, %2" : "=v"(r) : "v"(lo), "v"(hi)); return r; }
typedef float f32x2 __attribute__((ext_vector_type(2)));
__device__ __forceinline__ f32x2 gelu_pk(f32x2 v) {
    const f32x2 av = __builtin_elementwise_abs(v), d = av * 0.2316418882f + 1.0f;
    f32x2 t; t.x = __builtin_amdgcn_rcpf(d.x); t.y = __builtin_amdgcn_rcpf(d.y);
    f32x2 q = t * 0.5307027145f + (-0.7265760135f); q = q * t + 0.7107068705f; q = q * t + (-0.142248368f); q = q * t + 0.127414796f; q = q * t;
    const f32x2 s = (v * v) * (-0.72134752044f);
    f32x2 e; e.x = __builtin_amdgcn_exp2f(s.x); e.y = __builtin_amdgcn_exp2f(s.y);
    const f32x2 m = v * (q * e), r = v - m;
    f32x2 o; o.x = v.x < 0.f ? m.x : r.x; o.y = v.y < 0.f ? m.y : r.y; return o;
}


constexpr float RMS_EPS = 1e-6f;
__device__ __forceinline__ float rs_from_ss(float ss, float inv_n) { return __builtin_amdgcn_rsqf(ss * inv_n + RMS_EPS); }
__device__ __forceinline__ float silu_f(float g) { return g * __builtin_amdgcn_rcpf(1.0f + __builtin_amdgcn_exp2f(g * -1.4426950408889634f)); }
__device__ __forceinline__ float sigmoid_f(float g) { return __builtin_amdgcn_rcpf(1.0f + __builtin_amdgcn_exp2f(g * -1.4426950408889634f)); }
typedef unsigned u32x2 __attribute__((ext_vector_type(2)));

struct EpiSwiGLU {
    static constexpr bool PERM = true, AFTER_DRAIN = false;
    bf16_t* O; int ldc; const float* ss;
    __device__ __forceinline__ void operator()(const f32x4 (&acc)[2][2][4][2], const Unit& u, int wr, int wc, int fr, int fq) const {
        const int row0 = u.pm * BM + wr * 64 + fr; const int col0 = u.pn * HALF + wc * 32 + 8 * fq;
#pragma unroll
        for (int ai = 0; ai < 2; ++ai)
#pragma unroll
            for (int m = 0; m < 4; ++m) { const int row = row0 + ai * HALF + m * 16; const float r = rs_from_ss(ss[row], 1.0f / 1024.0f);
                const f32x4 g0 = acc[ai][0][m][0] * r, g1 = acc[ai][0][m][1] * r, u0 = acc[ai][1][m][0] * r, u1 = acc[ai][1][m][1] * r;
                u32x4 w; w.x = cvt_pk_bf16(silu_f(g0[0]) * u0[0], silu_f(g0[1]) * u0[1]); w.y = cvt_pk_bf16(silu_f(g0[2]) * u0[2], silu_f(g0[3]) * u0[3]);
                w.z = cvt_pk_bf16(silu_f(g1[0]) * u1[0], silu_f(g1[1]) * u1[1]); w.w = cvt_pk_bf16(silu_f(g1[2]) * u1[2], silu_f(g1[3]) * u1[3]);
                *(u32x4*)(O + (size_t)row * ldc + col0) = w; }
    }
};

struct EpiResid {
    static constexpr bool PERM = false, AFTER_DRAIN = false;
    const float* res; float* out; bf16_t* ob; float* ssout; float alpha; int ldc;
    __device__ __forceinline__ void operator()(const f32x4 (&acc)[2][2][4][2], const Unit& u, int wr, int wc, int fr, int fq) const {
        const int row0 = u.pm * BM + wr * 64 + fr, col0 = u.pn * BM + wc * 32 + 4 * fq;
#pragma unroll
        for (int ai = 0; ai < 2; ++ai)
#pragma unroll
            for (int m = 0; m < 4; ++m) { const int row = row0 + ai * HALF + m * 16; const size_t off = (size_t)row * ldc + col0; float sq = 0.f;
#pragma unroll
                for (int bj = 0; bj < 2; ++bj)
#pragma unroll
                    for (int n = 0; n < 2; ++n) { const size_t o2 = off + bj * HALF + n * 16; const f32x4 rv = *(const f32x4*)(res + o2); const f32x4 o = rv + acc[ai][bj][m][n] * alpha;
                        *(f32x4*)(out + o2) = o; sq += (o[0] * o[0] + o[1] * o[1]) + (o[2] * o[2] + o[3] * o[3]);
                        u32x2 w; w.x = cvt_pk_bf16(o[0], o[1]); w.y = cvt_pk_bf16(o[2], o[3]); *(u32x2*)(ob + o2) = w; }
                sq += __shfl_xor(sq, 16); sq += __shfl_xor(sq, 32);
                if (fq == 0) atomicAdd(ssout + row, sq); asm volatile("" ::: "memory"); }
    }
};

struct EpiMixTok {
    static constexpr bool PERM = true, AFTER_DRAIN = false;
    bf16_t* O; int ldc; const float* ss;
    __device__ __forceinline__ void operator()(const f32x4 (&acc)[2][2][4][2], const Unit& u, int wr, int wc, int fr, int fq) const {
        const int row0 = u.pm * BM + wr * 64 + fr; const int col0 = u.pn * BM + wc * 32 + 8 * fq;
        const bool isu = u.pn < 2; const float sc = (u.pn == 2 || u.pn == 3) ? 0.125f : 1.0f;
#pragma unroll
        for (int ai = 0; ai < 2; ++ai)
#pragma unroll
            for (int m = 0; m < 4; ++m) { const int row = row0 + ai * HALF + m * 16; const float r = rs_from_ss(ss[row], 1.0f / 1024.0f) * sc;
#pragma unroll
                for (int bj = 0; bj < 2; ++bj) { f32x4 v0 = acc[ai][bj][m][0] * r, v1 = acc[ai][bj][m][1] * r;
                    if (isu) { const f32x2 a = gelu_pk((f32x2){v0[0], v0[1]}), b = gelu_pk((f32x2){v0[2], v0[3]}), c = gelu_pk((f32x2){v1[0], v1[1]}), d = gelu_pk((f32x2){v1[2], v1[3]});
                        v0 = (f32x4){a.x, a.y, b.x, b.y}; v1 = (f32x4){c.x, c.y, d.x, d.y}; }
                    u32x4 w; w.x = cvt_pk_bf16(v0[0], v0[1]); w.y = cvt_pk_bf16(v0[2], v0[3]); w.z = cvt_pk_bf16(v1[0], v1[1]); w.w = cvt_pk_bf16(v1[2], v1[3]);
                    *(u32x4*)(O + (size_t)row * ldc + col0 + bj * HALF) = w; } }
    }
};

struct EpiMixT {
    static constexpr bool PERM = true, AFTER_DRAIN = false;
    bf16_t* O; int ldc; const float* ss; float* ssgv;
    __device__ __forceinline__ void operator()(const f32x4 (&acc)[2][2][4][2], const Unit& u, int wr, int wc, int fr, int fq) const {
        const int row0 = u.pm * BM + wr * 64 + fr; const int col0 = u.pn * BM + wc * 32 + 8 * fq;
        const bool isg = u.pm < 2;
        f32x4 rt[2][2], cs[2][2];
#pragma unroll
        for (int bj = 0; bj < 2; ++bj)
#pragma unroll
            for (int n = 0; n < 2; ++n) { const f32x4 s = *(const f32x4*)(ss + col0 + bj * HALF + 4 * n);
                rt[bj][n] = (f32x4){rs_from_ss(s[0], 1.0f / 1024.0f), rs_from_ss(s[1], 1.0f / 1024.0f), rs_from_ss(s[2], 1.0f / 1024.0f), rs_from_ss(s[3], 1.0f / 1024.0f)};
                cs[bj][n] = (f32x4){0.f, 0.f, 0.f, 0.f}; }
#pragma unroll
        for (int ai = 0; ai < 2; ++ai)
#pragma unroll
            for (int m = 0; m < 4; ++m) { const int row = row0 + ai * HALF + m * 16;
#pragma unroll
                for (int bj = 0; bj < 2; ++bj) { f32x4 v0 = acc[ai][bj][m][0] * rt[bj][0], v1 = acc[ai][bj][m][1] * rt[bj][1];
                    if (isg) { const f32x2 a = gelu_pk((f32x2){v0[0], v0[1]}), b = gelu_pk((f32x2){v0[2], v0[3]}), c = gelu_pk((f32x2){v1[0], v1[1]}), d = gelu_pk((f32x2){v1[2], v1[3]});
                        v0 = (f32x4){a.x, a.y, b.x, b.y}; v1 = (f32x4){c.x, c.y, d.x, d.y}; cs[bj][0] += v0 * v0; cs[bj][1] += v1 * v1; }
                    u32x4 w; w.x = cvt_pk_bf16(v0[0], v0[1]); w.y = cvt_pk_bf16(v0[2], v0[3]); w.z = cvt_pk_bf16(v1[0], v1[1]); w.w = cvt_pk_bf16(v1[2], v1[3]);
                    *(u32x4*)(O + (size_t)row * ldc + col0 + bj * HALF) = w; } }
        if (isg) {
            float mine = 0.f;
#pragma unroll
            for (int bj = 0; bj < 2; ++bj)
#pragma unroll
                for (int n = 0; n < 2; ++n)
#pragma unroll
                    for (int i = 0; i < 4; ++i) { float v = cs[bj][n][i]; v += __shfl_xor(v, 1); v += __shfl_xor(v, 2); v += __shfl_xor(v, 4); v += __shfl_xor(v, 8);
                        mine = (fr == bj * 8 + n * 4 + i) ? v : mine; }
            const int tok = col0 + (fr >> 3) * HALF + (fr & 7);
            atomicAdd(ssgv + tok, mine);
        }
    }
};

struct EpiPP {
    static constexpr bool PERM = false, AFTER_DRAIN = false;
    u32x4* slab;
    __device__ __forceinline__ void operator()(const f32x4 (&acc)[2][2][4][2], const Unit& u, int wr, int wc, int fr, int fq) const {
        u32x4* p = slab + (size_t)(u.pm * 4 + u.pn) * 16 * 512 + threadIdx.x;
#pragma unroll
        for (int ai = 0; ai < 2; ++ai)
#pragma unroll
            for (int bj = 0; bj < 2; ++bj)
#pragma unroll
                for (int m = 0; m < 4; ++m) { const f32x4 v0 = acc[ai][bj][m][0], v1 = acc[ai][bj][m][1];
                    u32x4 w; w.x = cvt_pk_bf16(v0[0], v0[1]); w.y = cvt_pk_bf16(v0[2], v0[3]); w.z = cvt_pk_bf16(v1[0], v1[1]); w.w = cvt_pk_bf16(v1[2], v1[3]);
                    p[(size_t)((ai * 2 + bj) * 4 + m) * 512] = w; }
    }
};
__device__ __forceinline__ float bf_lo(unsigned w) { return __uint_as_float(w << 16); }
__device__ __forceinline__ float bf_hi(unsigned w) { return __uint_as_float(w & 0xffff0000u); }
struct EpiGate {
    static constexpr bool PERM = false, AFTER_DRAIN = false;
    const float* res; float* out; const u32x4* slab; const float* ss; float* ssout; int ldc;
    __device__ __forceinline__ void operator()(const f32x4 (&acc)[2][2][4][2], const Unit& u, int wr, int wc, int fr, int fq) const {
        const int row0 = u.pm * BM + wr * 64 + fr, col0 = u.pn * BM + wc * 32 + 4 * fq;
        const u32x4* p = slab + (size_t)(u.pm * 4 + u.pn) * 16 * 512 + threadIdx.x;
#pragma unroll
        for (int ai = 0; ai < 2; ++ai)
#pragma unroll
            for (int m = 0; m < 4; ++m) { const int row = row0 + ai * HALF + m * 16; const size_t off = (size_t)row * ldc + col0; float sq = 0.f;
                const float r = rs_from_ss(ss[row], 1.0f / 1024.0f);
#pragma unroll
                for (int bj = 0; bj < 2; ++bj) { const u32x4 pw = p[(size_t)((ai * 2 + bj) * 4 + m) * 512];
                    const f32x4 pp0 = (f32x4){bf_lo(pw.x), bf_hi(pw.x), bf_lo(pw.y), bf_hi(pw.y)}, pp1 = (f32x4){bf_lo(pw.z), bf_hi(pw.z), bf_lo(pw.w), bf_hi(pw.w)};
#pragma unroll
                    for (int n = 0; n < 2; ++n) { const size_t o2 = off + bj * HALF + n * 16; const f32x4 rv = *(const f32x4*)(res + o2); const f32x4 a = acc[ai][bj][m][n] * r; const f32x4 pp = n ? pp1 : pp0;
                        f32x4 o; o[0] = rv[0] + sigmoid_f(a[0]) * pp[0]; o[1] = rv[1] + sigmoid_f(a[1]) * pp[1]; o[2] = rv[2] + sigmoid_f(a[2]) * pp[2]; o[3] = rv[3] + sigmoid_f(a[3]) * pp[3];
                        *(f32x4*)(out + o2) = o; sq += (o[0] * o[0] + o[1] * o[1]) + (o[2] * o[2] + o[3] * o[3]); } }
                sq += __shfl_xor(sq, 16); sq += __shfl_xor(sq, 32);
                if (fq == 0) atomicAdd(ssout + row, sq); asm volatile("" ::: "memory"); }
    }
};
template <class Epi, class Sched, bool ALIGN_EPI = false, bool SP2 = false>
__device__ __forceinline__ void gemm_phase(PG8_LAS unsigned char* lds, const Gemm g, const Sched& S, const Epi& E) {
    const int tid = threadIdx.x, wid = __builtin_amdgcn_readfirstlane(tid >> 6), lane = tid & 63, wr = wid >> 2, wc = wid & 3, fr = lane & 15, fq = lane >> 4;
    const int K = g.K, nt = K / BK;
    unsigned voffA[2], voffB[2];
#pragma unroll
    for (int i = 0; i < 2; ++i) { int R, C; stage_rc(tid * 16 + i * 8192, R, C); const int Rb = Epi::PERM ? ((R & ~31) + perm32(R & 31)) : R;
        voffA[i] = (unsigned)(R * K + C) * 2u; voffB[i] = (unsigned)(Rb * K + C) * 2u; }
    const size_t kstep = (size_t)(BK * 2);
    const size_t hstep = (size_t)HALF * K * 2;
    const size_t tstep = 2 * hstep;
    const unsigned ldsw = (unsigned)wid * 1024u;
    const int aoff = lds_byte(wr * 64 + fr, fq * 8), boff = lds_byte(wc * 32 + fr, fq * 8);
#define PG8_SA(b, h) (((b) * 2 + (h)) * HTB)
#define PG8_SB(b, h) ((4 + (b) * 2 + (h)) * HTB)
#define PG8_STAGE(bufoff, gbase, voff) do { _Pragma("unroll") for (int _i = 0; _i < 2; ++_i) \
        __builtin_amdgcn_global_load_lds((const unsigned*)((const char*)(gbase) + (voff)[_i]), (PG8_LAS unsigned*)(lds + (bufoff) + ldsw + _i * 8192), 16, 0, 0); } while (0)
#define PG8_LDA(dst, b, h) do { _Pragma("unroll") for (int m = 0; m < 4; ++m) _Pragma("unroll") for (int k = 0; k < 2; ++k) dst[m][k] = *(const PG8_LAS bf16x8*)(lds + PG8_SA(b, h) + aoff + m * 2048 + k * 1024); } while (0)
#define PG8_LDB(dst, b, h) do { _Pragma("unroll") for (int n = 0; n < 2; ++n) _Pragma("unroll") for (int k = 0; k < 2; ++k) dst[n][k] = *(const PG8_LAS bf16x8*)(lds + PG8_SB(b, h) + boff + n * 2048 + k * 1024); } while (0)
#define PG8_MMA(ai, bj, At, Bt) do { __builtin_amdgcn_s_setprio(1); _Pragma("unroll") for (int m = 0; m < 4; ++m) _Pragma("unroll") for (int n = 0; n < 2; ++n) _Pragma("unroll") for (int k = 0; k < 2; ++k) \
        acc[ai][bj][m][n] = __builtin_amdgcn_mfma_f32_16x16x32_bf16(Bt[n][k], At[m][k], acc[ai][bj][m][n], 0, 0, 0); __builtin_amdgcn_s_setprio(0); } while (0)
#define PG8_WAIT_V(n) asm volatile("s_waitcnt vmcnt(" #n ")" ::: "memory")
#define PG8_WAIT_L(n) asm volatile("s_waitcnt lgkmcnt(" #n ")" ::: "memory")
#define PG8_BAR __builtin_amdgcn_s_barrier()
#define PG8_SCHED __builtin_amdgcn_sched_barrier(0)
    Unit cur, nxt; int ui = 0;
    if (!S.next(0, cur)) return;
    f32x4 acc[2][2][4][2];
#pragma unroll
    for (int a = 0; a < 2; ++a)
#pragma unroll
        for (int b = 0; b < 2; ++b)
#pragma unroll
            for (int m = 0; m < 4; ++m)
#pragma unroll
                for (int n = 0; n < 2; ++n) acc[a][b][m][n] = (f32x4){0.f, 0.f, 0.f, 0.f};
    bf16x8 At[4][2], B0[2][2], B1[2][2];
    const char* cA = (const char*)g.A + (size_t)cur.pm * tstep; const char* cB = (const char*)g.Bt + (size_t)cur.pn * tstep;
    S.a_ready(cur);
    if constexpr (SP2) {
        PG8_STAGE(PG8_SB(0, 0), cB, voffB); PG8_STAGE(PG8_SB(0, 1), cB + hstep, voffB); PG8_STAGE(PG8_SA(0, 0), cA, voffA); PG8_STAGE(PG8_SA(0, 1), cA + hstep, voffA);
        if (wr == 1) PG8_BAR;
        PG8_WAIT_V(2); PG8_BAR;
        PG8_STAGE(PG8_SB(1, 0), cB + kstep, voffB); PG8_STAGE(PG8_SA(1, 0), cA + kstep, voffA); PG8_STAGE(PG8_SB(1, 1), cB + hstep + kstep, voffB);
        PG8_WAIT_V(6); PG8_BAR;
    } else {
        PG8_STAGE(PG8_SB(0, 0), cB, voffB); PG8_STAGE(PG8_SA(0, 0), cA, voffA); PG8_STAGE(PG8_SB(0, 1), cB + hstep, voffB); PG8_STAGE(PG8_SA(0, 1), cA + hstep, voffA);
        if (wr == 1) PG8_BAR;
        PG8_WAIT_V(4); PG8_BAR;
        PG8_STAGE(PG8_SB(1, 0), cB + kstep, voffB); PG8_STAGE(PG8_SA(1, 0), cA + kstep, voffA); PG8_STAGE(PG8_SB(1, 1), cB + hstep + kstep, voffB);
        PG8_WAIT_V(6); PG8_BAR;
    }
    for (;;) {
        const bool has_next = S.next(ui + 1, nxt);
        const char* nA = has_next ? (const char*)g.A + (size_t)nxt.pm * tstep : cA; const char* nB = has_next ? (const char*)g.Bt + (size_t)nxt.pn * tstep : cB;
#pragma nounroll
        for (int t = 0; t < nt; t += 2) {
            const bool last = (t == nt - 2);
            const char* a1 = cA + (size_t)(t + 1) * kstep;
            const char* a2 = last ? nA : cA + (size_t)(t + 2) * kstep; const char* b2 = last ? nB : cB + (size_t)(t + 2) * kstep;
            const char* a3 = a2 + kstep; const char* b3 = b2 + kstep;
            if (last && has_next) S.a_ready(nxt);
            if constexpr (SP2) {
            PG8_LDB(B0, 0, 0); PG8_LDB(B1, 0, 1); PG8_SCHED; PG8_LDA(At, 0, 0); PG8_STAGE(PG8_SA(1, 1), a1 + hstep, voffA);
            PG8_WAIT_V(8); PG8_WAIT_L(0); PG8_BAR; PG8_MMA(0, 0, At, B0); PG8_MMA(0, 1, At, B1); PG8_BAR; PG8_SCHED;
            PG8_LDA(At, 0, 1); PG8_STAGE(PG8_SB(0, 0), b2, voffB); PG8_STAGE(PG8_SB(0, 1), b2 + hstep, voffB); PG8_STAGE(PG8_SA(0, 0), a2, voffA);
            PG8_WAIT_V(8); PG8_WAIT_L(0); PG8_BAR; PG8_MMA(1, 0, At, B0); PG8_MMA(1, 1, At, B1); PG8_BAR; PG8_SCHED;
            PG8_LDB(B0, 1, 0); PG8_LDB(B1, 1, 1); PG8_SCHED; PG8_LDA(At, 1, 0); PG8_STAGE(PG8_SA(0, 1), a2 + hstep, voffA);
            PG8_WAIT_V(8); PG8_WAIT_L(0); PG8_BAR; PG8_MMA(0, 0, At, B0); PG8_MMA(0, 1, At, B1); PG8_BAR; PG8_SCHED;
            PG8_LDA(At, 1, 1); PG8_STAGE(PG8_SB(1, 0), b3, voffB); PG8_STAGE(PG8_SB(1, 1), b3 + hstep, voffB); PG8_STAGE(PG8_SA(1, 0), a3, voffA);
            PG8_WAIT_V(8); PG8_WAIT_L(0); PG8_BAR; PG8_MMA(1, 0, At, B0); PG8_MMA(1, 1, At, B1); PG8_BAR; PG8_SCHED;
            } else {
            PG8_LDB(B0, 0, 0); PG8_SCHED; PG8_LDA(At, 0, 0); PG8_STAGE(PG8_SA(1, 1), a1 + hstep, voffA);
            PG8_WAIT_L(8); PG8_BAR; PG8_WAIT_L(0); PG8_MMA(0, 0, At, B0); PG8_BAR; PG8_SCHED;
            PG8_LDB(B1, 0, 1); PG8_STAGE(PG8_SB(0, 0), b2, voffB);
            PG8_BAR; PG8_WAIT_L(0); PG8_MMA(0, 1, At, B1); PG8_BAR;
            PG8_LDA(At, 0, 1); PG8_STAGE(PG8_SA(0, 0), a2, voffA);
            PG8_BAR; PG8_WAIT_L(0); PG8_MMA(1, 0, At, B0); PG8_BAR; PG8_SCHED;
            PG8_STAGE(PG8_SB(0, 1), b2 + hstep, voffB);
            PG8_WAIT_V(6); PG8_BAR; PG8_MMA(1, 1, At, B1); PG8_BAR;
            PG8_LDB(B0, 1, 0); PG8_SCHED; PG8_LDA(At, 1, 0); PG8_STAGE(PG8_SA(0, 1), a2 + hstep, voffA);
            PG8_WAIT_L(8); PG8_BAR; PG8_WAIT_L(0); PG8_MMA(0, 0, At, B0); PG8_BAR; PG8_SCHED;
            PG8_LDB(B1, 1, 1); PG8_STAGE(PG8_SB(1, 0), b3, voffB);
            PG8_BAR; PG8_WAIT_L(0); PG8_MMA(0, 1, At, B1); PG8_BAR;
            PG8_LDA(At, 1, 1); PG8_STAGE(PG8_SA(1, 0), a3, voffA);
            PG8_BAR; PG8_WAIT_L(0); PG8_MMA(1, 0, At, B0); PG8_BAR; PG8_SCHED;
            PG8_STAGE(PG8_SB(1, 1), b3 + hstep, voffB);
            PG8_WAIT_V(6); PG8_BAR; PG8_MMA(1, 1, At, B1); PG8_BAR;
            }
        }
        if constexpr (ALIGN_EPI) { if (wr == 0) PG8_BAR; }
        if constexpr (!Epi::AFTER_DRAIN) { E(acc, cur, wr, wc, fr, fq); S.done(cur); }
        if (!has_next) break;
#pragma unroll
        for (int a = 0; a < 2; ++a)
#pragma unroll
            for (int b = 0; b < 2; ++b)
#pragma unroll
                for (int m = 0; m < 4; ++m)
#pragma unroll
                    for (int n = 0; n < 2; ++n) acc[a][b][m][n] = (f32x4){0.f, 0.f, 0.f, 0.f};
        cur = nxt; cA = nA; cB = nB; ++ui;
        if constexpr (ALIGN_EPI) { if (wr == 1) PG8_BAR; }
    }
    PG8_WAIT_V(0);
    if constexpr (!ALIGN_EPI) { if (wr == 0) PG8_BAR; }
    PG8_BAR;
    if constexpr (Epi::AFTER_DRAIN) { E.fused(acc, cur, wr, wc, fr, fq, lds, wid, lane); S.done(cur); }
#undef PG8_SA
#undef PG8_SB
#undef PG8_STAGE
#undef PG8_LDA
#undef PG8_LDB
#undef PG8_MMA
#undef PG8_WAIT_V
#undef PG8_WAIT_L
#undef PG8_BAR
#undef PG8_SCHED
}
}

#include <hip/hip_cooperative_groups.h>
namespace cg = cooperative_groups;

#ifndef MK_N_LAUNCHES
#define MK_N_LAUNCHES 1
#endif
constexpr int NWAVES = 8;
constexpr int NPHASE = 10;
constexpr int BATCH = 8, SEQ = 4096, DM = 1024, MTOK = BATCH * SEQ, DFF = 2816, PLE = 256;
constexpr size_t MiB = 1u << 20;
constexpr size_t WS_SS = 0;
constexpr size_t WS_W1IN = 1 * MiB, WS_W1OUT = 12 * MiB, WS_WMIX = 18 * MiB, WS_WMO = 23 * MiB, WS_W2IN = 25 * MiB, WS_W2OUT = 36 * MiB, WS_WG = 42 * MiB, WS_WP = 44 * MiB;
constexpr size_t WS_HB = 45 * MiB;
constexpr size_t WS_MIXED = 109 * MiB;
constexpr size_t WS_PB = 173 * MiB;
constexpr size_t WS_BIG = 189 * MiB;
constexpr size_t WS_GVT = WS_BIG + 96 * MiB;
constexpr size_t WS_END = WS_BIG + 176 * MiB;
constexpr int RING_BYTES = 131072, LDS_BYTES = 147456;

typedef unsigned short bf16;
typedef float f32x4 __attribute__((ext_vector_type(4)));
typedef float f32x16 __attribute__((ext_vector_type(16)));
typedef short bf16x8 __attribute__((ext_vector_type(8)));
typedef short s16x4 __attribute__((ext_vector_type(4)));
typedef unsigned u32x4 __attribute__((ext_vector_type(4)));
typedef unsigned u32x2 __attribute__((ext_vector_type(2)));
#define LAS __attribute__((address_space(3)))

__device__ __forceinline__ unsigned pk2(float lo, float hi) { return pg8::cvt_pk_bf16(lo, hi); }
__device__ __forceinline__ float wave_sum(float v) {
#pragma unroll
    for (int o = 1; o < 64; o <<= 1) v += __shfl_xor(v, o);
    return v;
}
__device__ __forceinline__ int crow(int r, int hi) { return (r & 3) + 8 * (r >> 2) + 4 * hi; }

__device__ __forceinline__ void p0_transpose_item(const float* W, int K, int N, bf16* WT, const float* gain, int mapkind, LAS float* scr, int item, int lane) {
    const int nblk = N / 32, kb = item / nblk, nb = item % nblk, k0 = 64 * kb, n0 = 32 * nb;
    int d0 = n0;
    if (mapkind == 1) { const bool up = n0 >= DFF; const int j = up ? n0 - DFF : n0; d0 = (j >> 7) * 256 + (up ? 128 : 0) + (j & 127); }
    else if (mapkind == 2) { d0 = n0 < 512 ? n0 : n0 < 1024 ? 1536 + (n0 - 512) : n0 < 2048 ? 512 + (n0 - 1024) : n0; }
#pragma unroll 8
    for (int i = 0; i < 32; ++i) { const int kk = 2 * i + (lane >> 5); float v = W[(size_t)(k0 + kk) * N + n0 + (lane & 31)]; if (gain) v *= gain[k0 + kk]; scr[kk * 33 + (lane & 31)] = v; }
    asm volatile("s_waitcnt lgkmcnt(0)" ::: "memory");
    const int c = lane & 7;
#pragma unroll
    for (int j = 0; j < 4; ++j) { const int n = (lane >> 3) + 8 * j; const LAS float* s = scr + (8 * c) * 33 + n;
        u32x4 o; o.x = pk2(s[0 * 33], s[1 * 33]); o.y = pk2(s[2 * 33], s[3 * 33]); o.z = pk2(s[4 * 33], s[5 * 33]); o.w = pk2(s[6 * 33], s[7 * 33]);
        *(u32x4*)(WT + (size_t)(d0 + n) * K + k0 + 8 * c) = o; }
    asm volatile("s_waitcnt lgkmcnt(0)" ::: "memory");
}

struct Args { const float* in[18]; float* out; unsigned char* ws; int ph_lo, ph_hi; };

__device__ __forceinline__ void attn_wave_unit(const bf16* UQK, const bf16* VT, bf16* MIXED, int b, int h, int qi, int lane) {
    const int r32 = lane & 31, hi = lane >> 5;
    const size_t tokb = (size_t)b * SEQ; const int t0 = qi * 32;
    const bf16* qp = UQK + (tokb + t0 + r32) * 1536 + 512 + h * 64 + 8 * hi;
    bf16x8 qf[4];
#pragma unroll
    for (int d = 0; d < 4; ++d) qf[d] = *(const bf16x8*)(qp + 16 * d);
    f32x16 o0, o1;
#pragma unroll
    for (int i = 0; i < 16; ++i) { o0[i] = 0.f; o1[i] = 0.f; }
    float carry = 0.f;
    const bf16* kbase = UQK + (tokb + r32) * 1536 + 1024 + h * 64 + 8 * hi;
    const bf16* vbase = VT + (size_t)(512 + h * 64 + r32) * MTOK + tokb + 4 * hi;
    for (int kb = qi; kb >= 0; --kb) {
        const int s0 = kb * 32;
        bf16x8 kf[4];
#pragma unroll
        for (int d = 0; d < 4; ++d) kf[d] = *(const bf16x8*)(kbase + (size_t)s0 * 1536 + 16 * d);
        s16x4 vt[2][2][2];
#pragma unroll
        for (int db = 0; db < 2; ++db)
#pragma unroll
            for (int j = 0; j < 2; ++j)
#pragma unroll
                for (int e = 0; e < 2; ++e) vt[db][j][e] = *(const s16x4*)(vbase + (size_t)db * 32 * MTOK + s0 + 16 * j + 8 * e);
        f32x16 z;
#pragma unroll
        for (int i = 0; i < 16; ++i) z[i] = 0.f;
#pragma unroll
        for (int d = 0; d < 4; ++d) z = __builtin_amdgcn_mfma_f32_32x32x16_bf16(kf[d], qf[d], z, 0, 0, 0);
        const bool diag = (kb == qi);
        float l[16];
#pragma unroll
        for (int i = 0; i < 16; ++i) { const float zz = z[i]; const float e = __builtin_amdgcn_exp2f(-fabsf(zz) * 1.4426950408889634f);
            const float sp = fmaxf(zz, 0.f) + 0.6931471805599453f * __builtin_amdgcn_logf(1.0f + e);
            const bool valid = !diag || (crow(i, hi) < r32); l[i] = valid ? -sp : 0.f; }
        float Gs[4], Go[4], T[4];
#pragma unroll
        for (int g = 0; g < 4; ++g) { Gs[g] = (l[4 * g] + l[4 * g + 1]) + (l[4 * g + 2] + l[4 * g + 3]); Go[g] = __shfl_xor(Gs[g], 32); T[g] = Gs[g] + Go[g]; }
        float aft[4]; aft[3] = 0.f; aft[2] = T[3]; aft[1] = T[3] + T[2]; aft[0] = aft[1] + T[1];
        const float total = aft[0] + T[0];
        float a[16];
#pragma unroll
        for (int g = 0; g < 4; ++g) { float run = aft[g] + (hi == 0 ? Go[g] : 0.f) + carry;
#pragma unroll
            for (int j = 3; j >= 0; --j) { const int i = 4 * g + j; run += l[i]; const bool valid = !diag || (crow(i, hi) < r32);
                a[i] = valid ? __builtin_amdgcn_exp2f((z[i] + run) * 1.4426950408889634f) : 0.f; } }
        carry += total;
        u32x4 p0, p1;
        p0.x = pk2(a[0], a[1]); p0.y = pk2(a[2], a[3]); p0.z = pk2(a[4], a[5]); p0.w = pk2(a[6], a[7]);
        p1.x = pk2(a[8], a[9]); p1.y = pk2(a[10], a[11]); p1.z = pk2(a[12], a[13]); p1.w = pk2(a[14], a[15]);
        const bf16x8 pb0 = __builtin_bit_cast(bf16x8, p0), pb1 = __builtin_bit_cast(bf16x8, p1);
#define VFRAG(db, j) (bf16x8){vt[db][j][0][0], vt[db][j][0][1], vt[db][j][0][2], vt[db][j][0][3], vt[db][j][1][0], vt[db][j][1][1], vt[db][j][1][2], vt[db][j][1][3]}
        o0 = __builtin_amdgcn_mfma_f32_32x32x16_bf16(VFRAG(0, 0), pb0, o0, 0, 0, 0);
        o0 = __builtin_amdgcn_mfma_f32_32x32x16_bf16(VFRAG(0, 1), pb1, o0, 0, 0, 0);
        o1 = __builtin_amdgcn_mfma_f32_32x32x16_bf16(VFRAG(1, 0), pb0, o1, 0, 0, 0);
        o1 = __builtin_amdgcn_mfma_f32_32x32x16_bf16(VFRAG(1, 1), pb1, o1, 0, 0, 0);
#undef VFRAG
        if (__all(carry < -40.0f)) break;
    }
    bf16* op = MIXED + (tokb + t0 + r32) * 1024 + 512 + h * 64 + 4 * hi;
#pragma unroll
    for (int g = 0; g < 4; ++g) {
        u32x2 w0; w0.x = pk2(o0[4 * g], o0[4 * g + 1]); w0.y = pk2(o0[4 * g + 2], o0[4 * g + 3]); *(u32x2*)(op + 8 * g) = w0;
        u32x2 w1; w1.x = pk2(o1[4 * g], o1[4 * g + 1]); w1.y = pk2(o1[4 * g + 2], o1[4 * g + 3]); *(u32x2*)(op + 32 + 8 * g) = w1; }
}

__device__ __forceinline__ void gmlp_unit(const bf16* UQK, const bf16* GVT, bf16* MIXED, const float* w_s, const float* b_s, const float* vgain, const float* ssgv, int b, int c, int h, int wave, int lane) {
    const int r32 = lane & 31, hi = lane >> 5, tb = wave >> 1, dbp = wave & 1;
    const size_t tokbase = (size_t)b * SEQ + (size_t)c * 128; const int t0 = 32 * tb, t = t0 + r32;
    const float* wrow = w_s + ((size_t)h * 128 + t) * 128 + 8 * hi;
    f32x16 acc0, acc1;
#pragma unroll
    for (int i = 0; i < 16; ++i) { acc0[i] = 0.f; acc1[i] = 0.f; }
    const int nks = 2 * (tb + 1);
    const bf16* g0p = GVT + (size_t)(h * 128 + 64 * dbp + r32) * MTOK + tokbase + 8 * hi;
    for (int ks = 0; ks < nks; ++ks) {
        const int s = 16 * ks + 8 * hi;
        const f32x4 w0 = *(const f32x4*)(wrow + 16 * ks), w1 = *(const f32x4*)(wrow + 16 * ks + 4);
        const f32x4 q0 = *(const f32x4*)(ssgv + tokbase + s), q1 = *(const f32x4*)(ssgv + tokbase + s + 4);
        float v[8];
#pragma unroll
        for (int e = 0; e < 4; ++e) { v[e] = (s + e <= t) ? w0[e] * pg8::rs_from_ss(q0[e], 1.0f / 512.0f) : 0.f; v[4 + e] = (s + 4 + e <= t) ? w1[e] * pg8::rs_from_ss(q1[e], 1.0f / 512.0f) : 0.f; }
        u32x4 bw; bw.x = pk2(v[0], v[1]); bw.y = pk2(v[2], v[3]); bw.z = pk2(v[4], v[5]); bw.w = pk2(v[6], v[7]);
        const bf16x8 bfrag = __builtin_bit_cast(bf16x8, bw);
        const bf16x8 a0 = *(const bf16x8*)(g0p + 16 * ks), a1 = *(const bf16x8*)(g0p + (size_t)32 * MTOK + 16 * ks);
        acc0 = __builtin_amdgcn_mfma_f32_32x32x16_bf16(a0, bfrag, acc0, 0, 0, 0);
        acc1 = __builtin_amdgcn_mfma_f32_32x32x16_bf16(a1, bfrag, acc1, 0, 0, 0);
    }
    const float bb = b_s[h * 128 + t];
    const size_t tok = tokbase + t;
#pragma unroll
    for (int dd = 0; dd < 2; ++dd)
#pragma unroll
        for (int g = 0; g < 4; ++g) { const int col = h * 128 + 64 * dbp + 32 * dd + 8 * g + 4 * hi;
            const u32x2 gu = *(const u32x2*)(UQK + tok * 1536 + col); const f32x4 vg = *(const f32x4*)(vgain + col);
            float c0, c1, c2, c3; if (dd == 0) { c0 = acc0[4 * g]; c1 = acc0[4 * g + 1]; c2 = acc0[4 * g + 2]; c3 = acc0[4 * g + 3]; } else { c0 = acc1[4 * g]; c1 = acc1[4 * g + 1]; c2 = acc1[4 * g + 2]; c3 = acc1[4 * g + 3]; }
            u32x2 w; w.x = pk2(pg8::bf_lo(gu.x) * (vg[0] * c0 + bb), pg8::bf_hi(gu.x) * (vg[1] * c1 + bb)); w.y = pk2(pg8::bf_lo(gu.y) * (vg[2] * c2 + bb), pg8::bf_hi(gu.y) * (vg[3] * c3 + bb));
            *(u32x2*)(MIXED + tok * 1024 + col) = w; }
}

__global__ void __launch_bounds__(NWAVES * 64, 2) mk_fwd(Args args) {
    extern __shared__ __attribute__((aligned(16))) unsigned char lds_raw[];
    LAS unsigned char* lds = (LAS unsigned char*)lds_raw;
    const int tid = threadIdx.x, lane = tid & 63, wave = __builtin_amdgcn_readfirstlane(tid >> 6);
    const int G = gridDim.x, bx = blockIdx.x;
    const int gw = bx * NWAVES + wave, NGW = G * NWAVES;
#define ws (args.ws)
#define xin (args.in[0])
#define pin (args.in[1])
#define ssx ((float*)(ws + WS_SS))
#define ss1 (ssx + MTOK)
#define ssgv (ssx + 2 * MTOK)
#define ss2 (ssx + 3 * MTOK)
#define ss3 (ssx + 4 * MTOK)
#define ss4 (ssx + 5 * MTOK)
#define W1in ((bf16*)(ws + WS_W1IN))
#define W1out ((bf16*)(ws + WS_W1OUT))
#define Wmix ((bf16*)(ws + WS_WMIX))
#define Wmo ((bf16*)(ws + WS_WMO))
#define W2in ((bf16*)(ws + WS_W2IN))
#define W2out ((bf16*)(ws + WS_W2OUT))
#define Wg ((bf16*)(ws + WS_WG))
#define Wp ((bf16*)(ws + WS_WP))
#define HB ((bf16*)(ws + WS_HB))
#define MIXED ((bf16*)(ws + WS_MIXED))
#define PB ((bf16*)(ws + WS_PB))
#define HID ((bf16*)(ws + WS_BIG))
#define UQK ((bf16*)(ws + WS_BIG))
#define GVT ((bf16*)(ws + WS_GVT))
#define SLAB ((u32x4*)(ws + WS_BIG))
#define out (args.out)
    const int lo = args.ph_lo, hi_ph = args.ph_hi;
#ifndef PHASE_MASK
#define PHASE_MASK 0x3ff
#endif
#define IN(k) (((PHASE_MASK >> (k)) & 1) && lo <= (k) && (k) < hi_ph)
#define SEAM(k) do { if (IN(k) && IN((k) + 1)) { cg::this_grid().sync(); } } while (0)

    if (IN(0)) {
        LAS float* scr = (LAS float*)(lds + wave * 16384);
        constexpr int I_IN = (DM / 64) * (2 * DFF / 32), I_OUT = (DFF / 64) * (DM / 32), I_MIX = (DM / 64) * (2560 / 32), I_SQ = (DM / 64) * (DM / 32), I_P = (PLE / 64) * (DM / 32);
        constexpr int NITEMS = 2 * I_IN + 2 * I_OUT + I_MIX + 2 * I_SQ + I_P;
        for (int it = gw; it < NITEMS; it += NGW) {
            int r = it;
            if (r < I_IN) { p0_transpose_item(args.in[3], DM, 2 * DFF, W1in, args.in[2], 1, scr, r, lane); continue; } r -= I_IN;
            if (r < I_IN) { p0_transpose_item(args.in[12], DM, 2 * DFF, W2in, args.in[11], 1, scr, r, lane); continue; } r -= I_IN;
            if (r < I_OUT) { p0_transpose_item(args.in[4], DFF, DM, W1out, nullptr, 0, scr, r, lane); continue; } r -= I_OUT;
            if (r < I_OUT) { p0_transpose_item(args.in[13], DFF, DM, W2out, nullptr, 0, scr, r, lane); continue; } r -= I_OUT;
            if (r < I_MIX) { p0_transpose_item(args.in[6], DM, 2560, Wmix, args.in[5], 2, scr, r, lane); continue; } r -= I_MIX;
            if (r < I_SQ) { p0_transpose_item(args.in[10], DM, DM, Wmo, nullptr, 0, scr, r, lane); continue; } r -= I_SQ;
            if (r < I_SQ) { p0_transpose_item(args.in[15], DM, DM, Wg, args.in[14], 0, scr, r, lane); continue; } r -= I_SQ;
            p0_transpose_item(args.in[16], PLE, DM, Wp, nullptr, 0, scr, r, lane);
        }
        for (int m = gw; m < MTOK; m += NGW) {
            const f32x4* xr = (const f32x4*)(xin + (size_t)m * DM) + lane; f32x4 v[4]; float s = 0.f;
#pragma unroll
            for (int j = 0; j < 4; ++j) { v[j] = xr[64 * j]; s += (v[j][0] * v[j][0] + v[j][1] * v[j][1]) + (v[j][2] * v[j][2] + v[j][3] * v[j][3]); }
            s = wave_sum(s); if (lane == 0) ssx[m] = s;
            u32x2* o8 = (u32x2*)(HB + (size_t)m * DM) + lane;
#pragma unroll
            for (int j = 0; j < 4; ++j) { u32x2 w; w.x = pk2(v[j][0], v[j][1]); w.y = pk2(v[j][2], v[j][3]); o8[64 * j] = w; }
        }
        for (size_t i = (size_t)gw * 64 + lane; i < (size_t)MTOK * PLE / 8; i += (size_t)NGW * 64) {
            const f32x4 a = ((const f32x4*)pin)[2 * i], b = ((const f32x4*)pin)[2 * i + 1];
            u32x4 w; w.x = pk2(a[0], a[1]); w.y = pk2(a[2], a[3]); w.z = pk2(b[0], b[1]); w.w = pk2(b[2], b[3]); ((u32x4*)PB)[i] = w;
        }
        for (int i = gw * 64 + lane; i < 5 * MTOK; i += NGW * 64) ss1[i] = 0.f;
    }
    SEAM(0);
    if (IN(1)) {
        pg8::Gemm g{HB, W1in, MTOK, 2 * DFF, DM}; pg8::StaticOrder S; S.init(MTOK, 2 * DFF, G, bx);
        pg8::EpiSwiGLU E{HID, DFF, ssx};
        pg8::gemm_phase<pg8::EpiSwiGLU, pg8::StaticOrder, true, true>(lds, g, S, E);
    }
    SEAM(1);
    if (IN(2)) {
        pg8::Gemm g{HID, W1out, MTOK, DM, DFF}; pg8::StaticOrder S; S.init(MTOK, DM, G, bx);
        pg8::EpiResid E{xin, out, HB, ss1, 0.5f, DM};
        pg8::gemm_phase<pg8::EpiResid, pg8::StaticOrder, true, true>(lds, g, S, E);
    }
    SEAM(2);
    if (IN(3)) {
        { pg8::Gemm g{HB, Wmix, MTOK, 1536, DM}; pg8::StaticOrder S; S.init(MTOK, 1536, G, bx);
          pg8::EpiMixTok E{UQK, 1536, ss1};
          pg8::gemm_phase<pg8::EpiMixTok, pg8::StaticOrder, true, true>(lds, g, S, E); }
        { pg8::Gemm g{Wmix + (size_t)1536 * DM, HB, 1024, MTOK, DM}; pg8::StaticOrder S; S.init(1024, MTOK, G, bx);
          pg8::EpiMixT E{GVT, MTOK, ss1, ssgv};
          pg8::gemm_phase<pg8::EpiMixT, pg8::StaticOrder, true, true>(lds, g, S, E); }
    }
    SEAM(3);
    if (IN(4)) {
        for (int u = bx; u < BATCH * 32 * 4; u += G) { const int h = u & 3, c = (u >> 2) & 31, b = u >> 7;
            gmlp_unit(UQK, GVT, MIXED, args.in[8], args.in[9], args.in[7], ssgv, b, c, h, wave, lane); }
        for (int u = gw; u < BATCH * 8 * (SEQ / 32); u += NGW) { const int qi = u & 127, h = (u >> 7) & 7, b = u >> 10;
            attn_wave_unit(UQK, GVT, MIXED, b, h, qi, lane); }
    }
    SEAM(4);
    if (IN(5)) {
        pg8::Gemm g{MIXED, Wmo, MTOK, DM, DM}; pg8::StaticOrder S; S.init(MTOK, DM, G, bx);
        pg8::EpiResid E{out, out, HB, ss2, 1.0f, DM};
        pg8::gemm_phase<pg8::EpiResid, pg8::StaticOrder, true, true>(lds, g, S, E);
    }
    SEAM(5);
    if (IN(6)) {
        pg8::Gemm g{HB, W2in, MTOK, 2 * DFF, DM}; pg8::StaticOrder S; S.init(MTOK, 2 * DFF, G, bx);
        pg8::EpiSwiGLU E{HID, DFF, ss2};
        pg8::gemm_phase<pg8::EpiSwiGLU, pg8::StaticOrder, true, true>(lds, g, S, E);
    }
    SEAM(6);
    if (IN(7)) {
        pg8::Gemm g{HID, W2out, MTOK, DM, DFF}; pg8::StaticOrder S; S.init(MTOK, DM, G, bx);
        pg8::EpiResid E{out, out, HB, ss3, 0.5f, DM};
        pg8::gemm_phase<pg8::EpiResid, pg8::StaticOrder, true, true>(lds, g, S, E);
    }
    SEAM(7);
    if (IN(8)) {
#ifndef P8_NO_PP
        { pg8::Gemm g{PB, Wp, MTOK, DM, PLE}; pg8::StaticOrder S; S.init(MTOK, DM, G, bx);
          pg8::EpiPP E{SLAB};
          pg8::gemm_phase<pg8::EpiPP, pg8::StaticOrder, true, true>(lds, g, S, E); }
#endif
        asm volatile("s_waitcnt vmcnt(0)" ::: "memory");
#ifndef P8_NO_GATE
        { pg8::Gemm g{HB, Wg, MTOK, DM, DM}; pg8::StaticOrder S; S.init(MTOK, DM, G, bx);
          pg8::EpiGate E{out, out, SLAB, ss3, ss4, DM};
          pg8::gemm_phase<pg8::EpiGate, pg8::StaticOrder, true, true>(lds, g, S, E); }
#endif
    }
    SEAM(8);
    if (IN(9)) {
        const f32x4* gf = (const f32x4*)args.in[17] + lane; f32x4 gv[4];
#pragma unroll
        for (int j = 0; j < 4; ++j) gv[j] = gf[64 * j];
        for (int m = gw; m < MTOK; m += NGW) {
            f32x4* xr = (f32x4*)(out + (size_t)m * DM) + lane; const float r = pg8::rs_from_ss(ss4[m], 1.0f / 1024.0f);
#pragma unroll
            for (int j = 0; j < 4; ++j) xr[64 * j] = xr[64 * j] * r * gv[j];
        }
    }
#undef IN
#undef SEAM
#undef ws
#undef xin
#undef pin
#undef ssx
#undef ss1
#undef ssgv
#undef ss2
#undef ss3
#undef ss4
#undef W1in
#undef W1out
#undef Wmix
#undef Wmo
#undef W2in
#undef W2out
#undef Wg
#undef Wp
#undef HB
#undef MIXED
#undef PB
#undef HID
#undef UQK
#undef GVT
#undef SLAB
#undef out
}

extern "C" void kernel_launch(void* const* d_in, const int* in_sizes, int n_in, void* d_out, int out_size, void* d_ws, size_t ws_size, hipStream_t stream) {
    static int grid = 0;
    if (grid == 0) {
        if (n_in != 18 || out_size != MTOK * DM || ws_size < WS_END) { fprintf(stderr, "kernel_launch: unexpected shapes (n_in %d out %d ws %zu)\n", n_in, out_size, ws_size); grid = -1; return; }
        int dev = 0, cus = 0, per_cu = 0;
        hipGetDevice(&dev); hipDeviceGetAttribute(&cus, hipDeviceAttributeMultiprocessorCount, dev);
        hipFuncSetAttribute((const void*)mk_fwd, hipFuncAttributeMaxDynamicSharedMemorySize, LDS_BYTES);
        hipOccupancyMaxActiveBlocksPerMultiprocessor(&per_cu, (const void*)mk_fwd, NWAVES * 64, LDS_BYTES);
        if (per_cu < 1) { fprintf(stderr, "kernel_launch: occupancy query says %d blocks per CU\n", per_cu); per_cu = 1; }
        (void)hipGetLastError();
        grid = cus * per_cu;
    }
    if (grid < 0) return;
    Args a{};
    for (int i = 0; i < 18; ++i) a.in[i] = (const float*)d_in[i];
    a.out = (float*)d_out; a.ws = (unsigned char*)d_ws;
#if MK_N_LAUNCHES == 1
    a.ph_lo = 0; a.ph_hi = NPHASE;
    void* kargs[] = {&a};
    hipError_t e = hipLaunchCooperativeKernel((const void*)mk_fwd, dim3(grid), dim3(NWAVES * 64), kargs, LDS_BYTES, stream);
    if (e != hipSuccess) fprintf(stderr, "cooperative launch failed: %s (grid %d)\n", hipGetErrorString(e), grid);
#else
    for (int ph = 0; ph < NPHASE; ++ph) { a.ph_lo = ph; a.ph_hi = ph + 1; hipLaunchKernelGGL(mk_fwd, dim3(grid), dim3(NWAVES * 64), LDS_BYTES, stream, a); }
#endif
}
```

```cpp
#include <hip/hip_runtime.h>
#include <cstdio>
#include <cstdint>
#define MK_N_LAUNCHES 1
namespace pg8 {
#define PG8_LAS __attribute__((address_space(3)))
typedef unsigned short bf16_t;
typedef short bf16x8 __attribute__((ext_vector_type(8)));
typedef float f32x4 __attribute__((ext_vector_type(4)));
typedef unsigned u32x4 __attribute__((ext_vector_type(4)));
constexpr int BM = 256, BK = 64, HALF = 128, HTB = HALF * BK * 2  , STAGE_BYTES = 8 * HTB, NXCD = 8, WGM = 8;

__host__ __device__ __forceinline__ int lds_byte(int r, int c) { const int st = (r >> 4) * 2 + (c >> 5), rr = r & 15, cc = c & 31, ob = rr * 64 + cc * 2; return st * 1024 + (ob ^ (((ob >> 9) & 1) << 5)); }
__host__ __device__ __forceinline__ void stage_rc(int b, int& R, int& C) { const int st = b / 1024, sb = b % 1024, swz = sb ^ (((sb >> 9) & 1) << 5); R = (st >> 1) * 16 + swz / 64; C = (st & 1) * 32 + (swz % 64) / 2; }
__host__ __device__ __forceinline__ int perm32(int rho) { const int n = rho >> 4, i = rho & 15; return 8 * (i >> 2) + 4 * n + (i & 3); }

struct Unit { int pm, pn; };
struct Gemm { const bf16_t* A; const bf16_t* Bt; int M, N, K; };

struct StaticOrder {
    int nM, nN, nwg, G, c;
    __host__ __device__ void init(int M, int N, int G_, int c_) { nM = M / BM; nN = N / BM; nwg = nM * nN; G = G_; c = c_; }
    __host__ __device__ bool next(int i, Unit& u) const {
        const long L = (long)i * G + c; if (L >= nwg) return false;
        int wgid = (int)L; { const int q = nwg / NXCD, r = nwg % NXCD, xcd = wgid % NXCD, off = wgid / NXCD; wgid = (xcd < r ? xcd * (q + 1) : r * (q + 1) + (xcd - r) * q) + off; }
        const int nig = WGM * nN, gid = wgid / nig, fm = gid * WGM, gsz = (nM - fm) < WGM ? (nM - fm) : WGM;
        u.pm = fm + ((wgid % nig) % gsz); u.pn = (wgid % nig) / gsz; return true;
    }
    __device__ __forceinline__ void a_ready(const Unit&) const {}
    __device__ __forceinline__ void done(const Unit&) const {}
};

__device__ __forceinline__ unsigned cvt_pk_bf16(float lo, float hi) { unsigned r; asm volatile("v_cvt_pk_bf16_f32 %0, %1, %2" : "=v"(r) : "v"(lo), "v"(hi)); return r; }
typedef float f32x2 __attribute__((ext_vector_type(2)));
__device__ __forceinline__ f32x2 gelu_pk(f32x2 v) {
    const f32x2 av = __builtin_elementwise_abs(v), d = av * 0.2316418882f + 1.0f;
    f32x2 t; t.x = __builtin_amdgcn_rcpf(d.x); t.y = __builtin_amdgcn_rcpf(d.y);
    f32x2 q = t * 0.5307027145f + (-0.7265760135f); q = q * t + 0.7107068705f; q = q * t + (-0.142248368f); q = q * t + 0.127414796f; q = q * t;
    const f32x2 s = (v * v) * (-0.72134752044f);
    f32x2 e; e.x = __builtin_amdgcn_exp2f(s.x); e.y = __builtin_amdgcn_exp2f(s.y);
    const f32x2 m = v * (q * e), r = v - m;
    f32x2 o; o.x = v.x < 0.f ? m.x : r.x; o.y = v.y < 0.f ? m.y : r.y; return o;
}


constexpr float RMS_EPS = 1e-6f;
__device__ __forceinline__ float rs_from_ss(float ss, float inv_n) { return __builtin_amdgcn_rsqf(ss * inv_n + RMS_EPS); }
__device__ __forceinline__ float silu_f(float g) { return g * __builtin_amdgcn_rcpf(1.0f + __builtin_amdgcn_exp2f(g * -1.4426950408889634f)); }
__device__ __forceinline__ float sigmoid_f(float g) { return __builtin_amdgcn_rcpf(1.0f + __builtin_amdgcn_exp2f(g * -1.4426950408889634f)); }
typedef unsigned u32x2 __attribute__((ext_vector_type(2)));

struct EpiSwiGLU {
    static constexpr bool PERM = true, AFTER_DRAIN = false;
    bf16_t* O; int ldc; const float* ss;
    __device__ __forceinline__ void operator()(const f32x4 (&acc)[2][2][4][2], const Unit& u, int wr, int wc, int fr, int fq) const {
        const int row0 = u.pm * BM + wr * 64 + fr; const int col0 = u.pn * HALF + wc * 32 + 8 * fq;
#pragma unroll
        for (int ai = 0; ai < 2; ++ai)
#pragma unroll
            for (int m = 0; m < 4; ++m) { const int row = row0 + ai * HALF + m * 16; const float r = rs_from_ss(ss[row], 1.0f / 1024.0f);
                const f32x4 g0 = acc[ai][0][m][0] * r, g1 = acc[ai][0][m][1] * r, u0 = acc[ai][1][m][0] * r, u1 = acc[ai][1][m][1] * r;
                u32x4 w; w.x = cvt_pk_bf16(silu_f(g0[0]) * u0[0], silu_f(g0[1]) * u0[1]); w.y = cvt_pk_bf16(silu_f(g0[2]) * u0[2], silu_f(g0[3]) * u0[3]);
                w.z = cvt_pk_bf16(silu_f(g1[0]) * u1[0], silu_f(g1[1]) * u1[1]); w.w = cvt_pk_bf16(silu_f(g1[2]) * u1[2], silu_f(g1[3]) * u1[3]);
                *(u32x4*)(O + (size_t)row * ldc + col0) = w; }
    }
};

struct EpiResid {
    static constexpr bool PERM = false, AFTER_DRAIN = false;
    const float* res; float* out; bf16_t* ob; float* ssout; float alpha; int ldc;
    __device__ __forceinline__ void operator()(const f32x4 (&acc)[2][2][4][2], const Unit& u, int wr, int wc, int fr, int fq) const {
        const int row0 = u.pm * BM + wr * 64 + fr, col0 = u.pn * BM + wc * 32 + 4 * fq;
#pragma unroll
        for (int ai = 0; ai < 2; ++ai)
#pragma unroll
            for (int m = 0; m < 4; ++m) { const int row = row0 + ai * HALF + m * 16; const size_t off = (size_t)row * ldc + col0; float sq = 0.f;
#pragma unroll
                for (int bj = 0; bj < 2; ++bj)
#pragma unroll
                    for (int n = 0; n < 2; ++n) { const size_t o2 = off + bj * HALF + n * 16; const f32x4 rv = *(const f32x4*)(res + o2); const f32x4 o = rv + acc[ai][bj][m][n] * alpha;
                        *(f32x4*)(out + o2) = o; sq += (o[0] * o[0] + o[1] * o[1]) + (o[2] * o[2] + o[3] * o[3]);
                        u32x2 w; w.x = cvt_pk_bf16(o[0], o[1]); w.y = cvt_pk_bf16(o[2], o[3]); *(u32x2*)(ob + o2) = w; }
                sq += __shfl_xor(sq, 16); sq += __shfl_xor(sq, 32);
                if (fq == 0) atomicAdd(ssout + row, sq); asm volatile("" ::: "memory"); }
    }
};

struct EpiMixTok {
    static constexpr bool PERM = true, AFTER_DRAIN = false;
    bf16_t* O; int ldc; const float* ss;
    __device__ __forceinline__ void operator()(const f32x4 (&acc)[2][2][4][2], const Unit& u, int wr, int wc, int fr, int fq) const {
        const int row0 = u.pm * BM + wr * 64 + fr; const int col0 = u.pn * BM + wc * 32 + 8 * fq;
        const bool isu = u.pn < 2; const float sc = (u.pn == 2 || u.pn == 3) ? 0.125f : 1.0f;
#pragma unroll
        for (int ai = 0; ai < 2; ++ai)
#pragma unroll
            for (int m = 0; m < 4; ++m) { const int row = row0 + ai * HALF + m * 16; const float r = rs_from_ss(ss[row], 1.0f / 1024.0f) * sc;
#pragma unroll
                for (int bj = 0; bj < 2; ++bj) { f32x4 v0 = acc[ai][bj][m][0] * r, v1 = acc[ai][bj][m][1] * r;
                    if (isu) { const f32x2 a = gelu_pk((f32x2){v0[0], v0[1]}), b = gelu_pk((f32x2){v0[2], v0[3]}), c = gelu_pk((f32x2){v1[0], v1[1]}), d = gelu_pk((f32x2){v1[2], v1[3]});
                        v0 = (f32x4){a.x, a.y, b.x, b.y}; v1 = (f32x4){c.x, c.y, d.x, d.y}; }
                    u32x4 w; w.x = cvt_pk_bf16(v0[0], v0[1]); w.y = cvt_pk_bf16(v0[2], v0[3]); w.z = cvt_pk_bf16(v1[0], v1[1]); w.w = cvt_pk_bf16(v1[2], v1[3]);
                    *(u32x4*)(O + (size_t)row * ldc + col0 + bj * HALF) = w; } }
    }
};

struct EpiMixT {
    static constexpr bool PERM = true, AFTER_DRAIN = false;
    bf16_t* O; int ldc; const float* ss; float* ssgv;
    __device__ __forceinline__ void operator()(const f32x4 (&acc)[2][2][4][2], const Unit& u, int wr, int wc, int fr, int fq) const {
        const int row0 = u.pm * BM + wr * 64 + fr; const int col0 = u.pn * BM + wc * 32 + 8 * fq;
        const bool isg = u.pm < 2;
        f32x4 rt[2][2], cs[2][2];
#pragma unroll
        for (int bj = 0; bj < 2; ++bj)
#pragma unroll
            for (int n = 0; n < 2; ++n) { const f32x4 s = *(const f32x4*)(ss + col0 + bj * HALF + 4 * n);
                rt[bj][n] = (f32x4){rs_from_ss(s[0], 1.0f / 1024.0f), rs_from_ss(s[1], 1.0f / 1024.0f), rs_from_ss(s[2], 1.0f / 1024.0f), rs_from_ss(s[3], 1.0f / 1024.0f)};
                cs[bj][n] = (f32x4){0.f, 0.f, 0.f, 0.f}; }
#pragma unroll
        for (int ai = 0; ai < 2; ++ai)
#pragma unroll
            for (int m = 0; m < 4; ++m) { const int row = row0 + ai * HALF + m * 16;
#pragma unroll
                for (int bj = 0; bj < 2; ++bj) { f32x4 v0 = acc[ai][bj][m][0] * rt[bj][0], v1 = acc[ai][bj][m][1] * rt[bj][1];
                    if (isg) { const f32x2 a = gelu_pk((f32x2){v0[0], v0[1]}), b = gelu_pk((f32x2){v0[2], v0[3]}), c = gelu_pk((f32x2){v1[0], v1[1]}), d = gelu_pk((f32x2){v1[2], v1[3]});
                        v0 = (f32x4){a.x, a.y, b.x, b.y}; v1 = (f32x4){c.x, c.y, d.x, d.y}; cs[bj][0] += v0 * v0; cs[bj][1] += v1 * v1; }
                    u32x4 w; w.x = cvt_pk_bf16(v0[0], v0[1]); w.y = cvt_pk_bf16(v0[2], v0[3]); w.z = cvt_pk_bf16(v1[0], v1[1]); w.w = cvt_pk_bf16(v1[2], v1[3]);
                    *(u32x4*)(O + (size_t)row * ldc + col0 + bj * HALF) = w; } }
        if (isg) {
            float mine = 0.f;
#pragma unroll
            for (int bj = 0; bj < 2; ++bj)
#pragma unroll
                for (int n = 0; n < 2; ++n)
#pragma unroll
                    for (int i = 0; i < 4; ++i) { float v = cs[bj][n][i]; v += __shfl_xor(v, 1); v += __shfl_xor(v, 2); v += __shfl_xor(v, 4); v += __shfl_xor(v, 8);
                        mine = (fr == bj * 8 + n * 4 + i) ? v : mine; }
            const int tok = col0 + (fr >> 3) * HALF + (fr & 7);
            atomicAdd(ssgv + tok, mine);
        }
    }
};

struct EpiPP {
    static constexpr bool PERM = false, AFTER_DRAIN = false;
    u32x4* slab;
    __device__ __forceinline__ void operator()(const f32x4 (&acc)[2][2][4][2], const Unit& u, int wr, int wc, int fr, int fq) const {
        u32x4* p = slab + (size_t)(u.pm * 4 + u.pn) * 16 * 512 + threadIdx.x;
#pragma unroll
        for (int ai = 0; ai < 2; ++ai)
#pragma unroll
            for (int bj = 0; bj < 2; ++bj)
#pragma unroll
                for (int m = 0; m < 4; ++m) { const f32x4 v0 = acc[ai][bj][m][0], v1 = acc[ai][bj][m][1];
                    u32x4 w; w.x = cvt_pk_bf16(v0[0], v0[1]); w.y = cvt_pk_bf16(v0[2], v0[3]); w.z = cvt_pk_bf16(v1[0], v1[1]); w.w = cvt_pk_bf16(v1[2], v1[3]);
                    p[(size_t)((ai * 2 + bj) * 4 + m) * 512] = w; }
    }
};
__device__ __forceinline__ float bf_lo(unsigned w) { return __uint_as_float(w << 16); }
__device__ __forceinline__ float bf_hi(unsigned w) { return __uint_as_float(w & 0xffff0000u); }
struct EpiGate {
    static constexpr bool PERM = false, AFTER_DRAIN = false;
    const float* res; float* out; const u32x4* slab; const float* ss; float* ssout; int ldc;
    __device__ __forceinline__ void operator()(const f32x4 (&acc)[2][2][4][2], const Unit& u, int wr, int wc, int fr, int fq) const {
        const int row0 = u.pm * BM + wr * 64 + fr, col0 = u.pn * BM + wc * 32 + 4 * fq;
        const u32x4* p = slab + (size_t)(u.pm * 4 + u.pn) * 16 * 512 + threadIdx.x;
#pragma unroll
        for (int ai = 0; ai < 2; ++ai)
#pragma unroll
            for (int m = 0; m < 4; ++m) { const int row = row0 + ai * HALF + m * 16; const size_t off = (size_t)row * ldc + col0; float sq = 0.f;
                const float r = rs_from_ss(ss[row], 1.0f / 1024.0f);
#pragma unroll
                for (int bj = 0; bj < 2; ++bj) { const u32x4 pw = p[(size_t)((ai * 2 + bj) * 4 + m) * 512];
                    const f32x4 pp0 = (f32x4){bf_lo(pw.x), bf_hi(pw.x), bf_lo(pw.y), bf_hi(pw.y)}, pp1 = (f32x4){bf_lo(pw.z), bf_hi(pw.z), bf_lo(pw.w), bf_hi(pw.w)};
#pragma unroll
                    for (int n = 0; n < 2; ++n) { const size_t o2 = off + bj * HALF + n * 16; const f32x4 rv = *(const f32x4*)(res + o2); const f32x4 a = acc[ai][bj][m][n] * r; const f32x4 pp = n ? pp1 : pp0;
                        f32x4 o; o[0] = rv[0] + sigmoid_f(a[0]) * pp[0]; o[1] = rv[1] + sigmoid_f(a[1]) * pp[1]; o[2] = rv[2] + sigmoid_f(a[2]) * pp[2]; o[3] = rv[3] + sigmoid_f(a[3]) * pp[3];
                        *(f32x4*)(out + o2) = o; sq += (o[0] * o[0] + o[1] * o[1]) + (o[2] * o[2] + o[3] * o[3]); } }
                sq += __shfl_xor(sq, 16); sq += __shfl_xor(sq, 32);
                if (fq == 0) atomicAdd(ssout + row, sq); asm volatile("" ::: "memory"); }
    }
};
template <class Epi, class Sched, bool ALIGN_EPI = false, bool SP2 = false>
__device__ __forceinline__ void gemm_phase(PG8_LAS unsigned char* lds, const Gemm g, const Sched& S, const Epi& E) {
    const int tid = threadIdx.x, wid = __builtin_amdgcn_readfirstlane(tid >> 6), lane = tid & 63, wr = wid >> 2, wc = wid & 3, fr = lane & 15, fq = lane >> 4;
    const int K = g.K, nt = K / BK;
    unsigned voffA[2], voffB[2];
#pragma unroll
    for (int i = 0; i < 2; ++i) { int R, C; stage_rc(tid * 16 + i * 8192, R, C); const int Rb = Epi::PERM ? ((R & ~31) + perm32(R & 31)) : R;
        voffA[i] = (unsigned)(R * K + C) * 2u; voffB[i] = (unsigned)(Rb * K + C) * 2u; }
    const size_t kstep = (size_t)(BK * 2);
    const size_t hstep = (size_t)HALF * K * 2;
    const size_t tstep = 2 * hstep;
    const unsigned ldsw = (unsigned)wid * 1024u;
    const int aoff = lds_byte(wr * 64 + fr, fq * 8), boff = lds_byte(wc * 32 + fr, fq * 8);
#define PG8_SA(b, h) (((b) * 2 + (h)) * HTB)
#define PG8_SB(b, h) ((4 + (b) * 2 + (h)) * HTB)
#define PG8_STAGE(bufoff, gbase, voff) do { _Pragma("unroll") for (int _i = 0; _i < 2; ++_i) \
        __builtin_amdgcn_global_load_lds((const unsigned*)((const char*)(gbase) + (voff)[_i]), (PG8_LAS unsigned*)(lds + (bufoff) + ldsw + _i * 8192), 16, 0, 0); } while (0)
#define PG8_LDA(dst, b, h) do { _Pragma("unroll") for (int m = 0; m < 4; ++m) _Pragma("unroll") for (int k = 0; k < 2; ++k) dst[m][k] = *(const PG8_LAS bf16x8*)(lds + PG8_SA(b, h) + aoff + m * 2048 + k * 1024); } while (0)
#define PG8_LDB(dst, b, h) do { _Pragma("unroll") for (int n = 0; n < 2; ++n) _Pragma("unroll") for (int k = 0; k < 2; ++k) dst[n][k] = *(const PG8_LAS bf16x8*)(lds + PG8_SB(b, h) + boff + n * 2048 + k * 1024); } while (0)
#define PG8_MMA(ai, bj, At, Bt) do { __builtin_amdgcn_s_setprio(1); _Pragma("unroll") for (int m = 0; m < 4; ++m) _Pragma("unroll") for (int n = 0; n < 2; ++n) _Pragma("unroll") for (int k = 0; k < 2; ++k) \
        acc[ai][bj][m][n] = __builtin_amdgcn_mfma_f32_16x16x32_bf16(Bt[n][k], At[m][k], acc[ai][bj][m][n], 0, 0, 0); __builtin_amdgcn_s_setprio(0); } while (0)
#define PG8_WAIT_V(n) asm volatile("s_waitcnt vmcnt(" #n ")" ::: "memory")
#define PG8_WAIT_L(n) asm volatile("s_waitcnt lgkmcnt(" #n ")" ::: "memory")
#define PG8_BAR __builtin_amdgcn_s_barrier()
#define PG8_SCHED __builtin_amdgcn_sched_barrier(0)
    Unit cur, nxt; int ui = 0;
    if (!S.next(0, cur)) return;
    f32x4 acc[2][2][4][2];
#pragma unroll
    for (int a = 0; a < 2; ++a)
#pragma unroll
        for (int b = 0; b < 2; ++b)
#pragma unroll
            for (int m = 0; m < 4; ++m)
#pragma unroll
                for (int n = 0; n < 2; ++n) acc[a][b][m][n] = (f32x4){0.f, 0.f, 0.f, 0.f};
    bf16x8 At[4][2], B0[2][2], B1[2][2];
    const char* cA = (const char*)g.A + (size_t)cur.pm * tstep; const char* cB = (const char*)g.Bt + (size_t)cur.pn * tstep;
    S.a_ready(cur);
    if constexpr (SP2) {
        PG8_STAGE(PG8_SB(0, 0), cB, voffB); PG8_STAGE(PG8_SB(0, 1), cB + hstep, voffB); PG8_STAGE(PG8_SA(0, 0), cA, voffA); PG8_STAGE(PG8_SA(0, 1), cA + hstep, voffA);
        if (wr == 1) PG8_BAR;
        PG8_WAIT_V(2); PG8_BAR;
        PG8_STAGE(PG8_SB(1, 0), cB + kstep, voffB); PG8_STAGE(PG8_SA(1, 0), cA + kstep, voffA); PG8_STAGE(PG8_SB(1, 1), cB + hstep + kstep, voffB);
        PG8_WAIT_V(6); PG8_BAR;
    } else {
        PG8_STAGE(PG8_SB(0, 0), cB, voffB); PG8_STAGE(PG8_SA(0, 0), cA, voffA); PG8_STAGE(PG8_SB(0, 1), cB + hstep, voffB); PG8_STAGE(PG8_SA(0, 1), cA + hstep, voffA);
        if (wr == 1) PG8_BAR;
        PG8_WAIT_V(4); PG8_BAR;
        PG8_STAGE(PG8_SB(1, 0), cB + kstep, voffB); PG8_STAGE(PG8_SA(1, 0), cA + kstep, voffA); PG8_STAGE(PG8_SB(1, 1), cB + hstep + kstep, voffB);
        PG8_WAIT_V(6); PG8_BAR;
    }
    for (;;) {
        const bool has_next = S.next(ui + 1, nxt);
        const char* nA = has_next ? (const char*)g.A + (size_t)nxt.pm * tstep : cA; const char* nB = has_next ? (const char*)g.Bt + (size_t)nxt.pn * tstep : cB;
#pragma nounroll
        for (int t = 0; t < nt; t += 2) {
            const bool last = (t == nt - 2);
            const char* a1 = cA + (size_t)(t + 1) * kstep;
            const char* a2 = last ? nA : cA + (size_t)(t + 2) * kstep; const char* b2 = last ? nB : cB + (size_t)(t + 2) * kstep;
            const char* a3 = a2 + kstep; const char* b3 = b2 + kstep;
            if (last && has_next) S.a_ready(nxt);
            if constexpr (SP2) {
            PG8_LDB(B0, 0, 0); PG8_LDB(B1, 0, 1); PG8_SCHED; PG8_LDA(At, 0, 0); PG8_STAGE(PG8_SA(1, 1), a1 + hstep, voffA);
            PG8_WAIT_V(8); PG8_WAIT_L(0); PG8_BAR; PG8_MMA(0, 0, At, B0); PG8_MMA(0, 1, At, B1); PG8_BAR; PG8_SCHED;
            PG8_LDA(At, 0, 1); PG8_STAGE(PG8_SB(0, 0), b2, voffB); PG8_STAGE(PG8_SB(0, 1), b2 + hstep, voffB); PG8_STAGE(PG8_SA(0, 0), a2, voffA);
            PG8_WAIT_V(8); PG8_WAIT_L(0); PG8_BAR; PG8_MMA(1, 0, At, B0); PG8_MMA(1, 1, At, B1); PG8_BAR; PG8_SCHED;
            PG8_LDB(B0, 1, 0); PG8_LDB(B1, 1, 1); PG8_SCHED; PG8_LDA(At, 1, 0); PG8_STAGE(PG8_SA(0, 1), a2 + hstep, voffA);
            PG8_WAIT_V(8); PG8_WAIT_L(0); PG8_BAR; PG8_MMA(0, 0, At, B0); PG8_MMA(0, 1, At, B1); PG8_BAR; PG8_SCHED;
            PG8_LDA(At, 1, 1); PG8_STAGE(PG8_SB(1, 0), b3, voffB); PG8_STAGE(PG8_SB(1, 1), b3 + hstep, voffB); PG8_STAGE(PG8_SA(1, 0), a3, voffA);
            PG8_WAIT_V(8); PG8_WAIT_L(0); PG8_BAR; PG8_MMA(1, 0, At, B0); PG8_MMA(1, 1, At, B1); PG8_BAR; PG8_SCHED;
            } else {
            PG8_LDB(B0, 0, 0); PG8_SCHED; PG8_LDA(At, 0, 0); PG8_STAGE(PG8_SA(1, 1), a1 + hstep, voffA);
            PG8_WAIT_L(8); PG8_BAR; PG8_WAIT_L(0); PG8_MMA(0, 0, At, B0); PG8_BAR; PG8_SCHED;
            PG8_LDB(B1, 0, 1); PG8_STAGE(PG8_SB(0, 0), b2, voffB);
            PG8_BAR; PG8_WAIT_L(0); PG8_MMA(0, 1, At, B1); PG8_BAR;
            PG8_LDA(At, 0, 1); PG8_STAGE(PG8_SA(0, 0), a2, voffA);
            PG8_BAR; PG8_WAIT_L(0); PG8_MMA(1, 0, At, B0); PG8_BAR; PG8_SCHED;
            PG8_STAGE(PG8_SB(0, 1), b2 + hstep, voffB);
            PG8_WAIT_V(6); PG8_BAR; PG8_MMA(1, 1, At, B1); PG8_BAR;
            PG8_LDB(B0, 1, 0); PG8_SCHED; PG8_LDA(At, 1, 0); PG8_STAGE(PG8_SA(0, 1), a2 + hstep, voffA);
            PG8_WAIT_L(8); PG8_BAR; PG8_WAIT_L(0); PG8_MMA(0, 0, At, B0); PG8_BAR; PG8_SCHED;
            PG8_LDB(B1, 1, 1); PG8_STAGE(PG8_SB(1, 0), b3, voffB);
            PG8_BAR; PG8_WAIT_L(0); PG8_MMA(0, 1, At, B1); PG8_BAR;
            PG8_LDA(At, 1, 1); PG8_STAGE(PG8_SA(1, 0), a3, voffA);
            PG8_BAR; PG8_WAIT_L(0); PG8_MMA(1, 0, At, B0); PG8_BAR; PG8_SCHED;
            PG8_STAGE(PG8_SB(1, 1), b3 + hstep, voffB);
            PG8_WAIT_V(6); PG8_BAR; PG8_MMA(1, 1, At, B1); PG8_BAR;
            }
        }
        if constexpr (ALIGN_EPI) { if (wr == 0) PG8_BAR; }
        if constexpr (!Epi::AFTER_DRAIN) { E(acc, cur, wr, wc, fr, fq); S.done(cur); }
        if (!has_next) break;
#pragma unroll
        for (int a = 0; a < 2; ++a)
#pragma unroll
            for (int b = 0; b < 2; ++b)
#pragma unroll
                for (int m = 0; m < 4; ++m)
#pragma unroll
                    for (int n = 0; n < 2; ++n) acc[a][b][m][n] = (f32x4){0.f, 0.f, 0.f, 0.f};
        cur = nxt; cA = nA; cB = nB; ++ui;
        if constexpr (ALIGN_EPI) { if (wr == 1) PG8_BAR; }
    }
    PG8_WAIT_V(0);
    if constexpr (!ALIGN_EPI) { if (wr == 0) PG8_BAR; }
    PG8_BAR;
    if constexpr (Epi::AFTER_DRAIN) { E.fused(acc, cur, wr, wc, fr, fq, lds, wid, lane); S.done(cur); }
#undef PG8_SA
#undef PG8_SB
#undef PG8_STAGE
#undef PG8_LDA
#undef PG8_LDB
#undef PG8_MMA
#undef PG8_WAIT_V
#undef PG8_WAIT_L
#undef PG8_BAR
#undef PG8_SCHED
}
}

#include <hip/hip_cooperative_groups.h>
namespace cg = cooperative_groups;

#ifndef MK_N_LAUNCHES
#define MK_N_LAUNCHES 1
#endif
constexpr int NWAVES = 8;
constexpr int NPHASE = 10;
constexpr int BATCH = 8, SEQ = 4096, DM = 1024, MTOK = BATCH * SEQ, DFF = 2816, PLE = 256;
constexpr size_t MiB = 1u << 20;
constexpr size_t WS_SS = 0;
constexpr size_t WS_W1IN = 1 * MiB, WS_W1OUT = 12 * MiB, WS_WMIX = 18 * MiB, WS_WMO = 23 * MiB, WS_W2IN = 25 * MiB, WS_W2OUT = 36 * MiB, WS_WG = 42 * MiB, WS_WP = 44 * MiB;
constexpr size_t WS_HB = 45 * MiB;
constexpr size_t WS_MIXED = 109 * MiB;
constexpr size_t WS_PB = 173 * MiB;
constexpr size_t WS_BIG = 189 * MiB;
constexpr size_t WS_GVT = WS_BIG + 96 * MiB;
constexpr size_t WS_END = WS_BIG + 176 * MiB;
constexpr int RING_BYTES = 131072, LDS_BYTES = 147456;

typedef unsigned short bf16;
typedef float f32x4 __attribute__((ext_vector_type(4)));
typedef float f32x16 __attribute__((ext_vector_type(16)));
typedef short bf16x8 __attribute__((ext_vector_type(8)));
typedef short s16x4 __attribute__((ext_vector_type(4)));
typedef unsigned u32x4 __attribute__((ext_vector_type(4)));
typedef unsigned u32x2 __attribute__((ext_vector_type(2)));
#define LAS __attribute__((address_space(3)))

__device__ __forceinline__ unsigned pk2(float lo, float hi) { return pg8::cvt_pk_bf16(lo, hi); }
__device__ __forceinline__ float wave_sum(float v) {
#pragma unroll
    for (int o = 1; o < 64; o <<= 1) v += __shfl_xor(v, o);
    return v;
}
__device__ __forceinline__ int crow(int r, int hi) { return (r & 3) + 8 * (r >> 2) + 4 * hi; }

__device__ __forceinline__ void p0_transpose_item(const float* W, int K, int N, bf16* WT, const float* gain, int mapkind, LAS float* scr, int item, int lane) {
    const int nblk = N / 32, kb = item / nblk, nb = item % nblk, k0 = 64 * kb, n0 = 32 * nb;
    int d0 = n0;
    if (mapkind == 1) { const bool up = n0 >= DFF; const int j = up ? n0 - DFF : n0; d0 = (j >> 7) * 256 + (up ? 128 : 0) + (j & 127); }
    else if (mapkind == 2) { d0 = n0 < 512 ? n0 : n0 < 1024 ? 1536 + (n0 - 512) : n0 < 2048 ? 512 + (n0 - 1024) : n0; }
#pragma unroll 8
    for (int i = 0; i < 32; ++i) { const int kk = 2 * i + (lane >> 5); float v = W[(size_t)(k0 + kk) * N + n0 + (lane & 31)]; if (gain) v *= gain[k0 + kk]; scr[kk * 33 + (lane & 31)] = v; }
    asm volatile("s_waitcnt lgkmcnt(0)" ::: "memory");
    const int c = lane & 7;
#pragma unroll
    for (int j = 0; j < 4; ++j) { const int n = (lane >> 3) + 8 * j; const LAS float* s = scr + (8 * c) * 33 + n;
        u32x4 o; o.x = pk2(s[0 * 33], s[1 * 33]); o.y = pk2(s[2 * 33], s[3 * 33]); o.z = pk2(s[4 * 33], s[5 * 33]); o.w = pk2(s[6 * 33], s[7 * 33]);
        *(u32x4*)(WT + (size_t)(d0 + n) * K + k0 + 8 * c) = o; }
    asm volatile("s_waitcnt lgkmcnt(0)" ::: "memory");
}

#define XB_TMO      128
#define XB_XCNT(j)  (256  + 64 * (j))
#define XB_XSUB(j)  (1280 + 64 * (j))
#define XB_XGEN(j)  (2304 + 64 * (j))
#define XB_TOP      3328
#define XB_TOPGEN   3392
#define XCD_BAR_WORDS 3456
#define XB_SPIN_CAP (1u << 18)

__device__ __forceinline__ unsigned xb_ld(unsigned* p)              { return __hip_atomic_load(p, __ATOMIC_RELAXED, __HIP_MEMORY_SCOPE_AGENT); }
__device__ __forceinline__ unsigned xb_add(unsigned* p, unsigned v) { return __hip_atomic_fetch_add(p, v, __ATOMIC_RELAXED, __HIP_MEMORY_SCOPE_AGENT); }
__device__ __forceinline__ unsigned xb_xcc_id() { return (unsigned)__builtin_amdgcn_s_getreg((3 << 11) | 20) & 0xFu; }
#define XB_SPIN(cond, bar) do { unsigned _sp = 0; while (cond) { __builtin_amdgcn_s_sleep(1); \
    if ((++_sp & 255u) == 0u) { if (xb_ld(&(bar)[XB_TMO])) break; if (_sp > XB_SPIN_CAP) { atomicAdd(&(bar)[XB_TMO], 1u); break; } } } } while (0)

struct XcdBarrier {
    unsigned* bar; unsigned x;
    volatile LAS unsigned* st;
};

__device__ __forceinline__ XcdBarrier xcd_barrier_post(unsigned* bar, volatile LAS unsigned* st) {
    XcdBarrier b; b.bar = bar; b.x = xb_xcc_id(); b.st = st;
    if (threadIdx.x == 0) (void)xb_add(&bar[XB_XCNT(b.x)], 1u);
    return b;
}
__device__ __forceinline__ void xcd_barrier_complete(unsigned* bar, unsigned x, unsigned& nloc, unsigned& nx) {
    const unsigned G = gridDim.x * gridDim.y * gridDim.z;
    unsigned sum, cnt, mine, sp = 0u;
    for (;;) {
        sum = 0u; cnt = 0u; mine = 0u;
#pragma unroll
        for (unsigned j = 0; j < 16; ++j) { const unsigned c = xb_ld(&bar[XB_XCNT(j)]); sum += c; cnt += (c > 0u) ? 1u : 0u; mine = (j == x) ? c : mine; }
        if (sum == G) break;
        __builtin_amdgcn_s_sleep(1);
        if ((++sp & 255u) == 0u) { if (xb_ld(&bar[XB_TMO])) break; if (sp > XB_SPIN_CAP) { atomicAdd(&bar[XB_TMO], 1u); break; } }
    }
    nloc = mine > 0u ? mine : 1u; nx = cnt > 0u ? cnt : 1u;
}

__device__ __forceinline__ void xcd_barrier(const XcdBarrier& b) {
    asm volatile("s_waitcnt vmcnt(0)" ::: "memory");
    __syncthreads();
    if (threadIdx.x == 0) {
        unsigned* bar = b.bar;
        __builtin_amdgcn_s_waitcnt(0);
        unsigned nloc = b.st[0], nx = b.st[1];
        if (nloc == 0u) { xcd_barrier_complete(bar, b.x, nloc, nx); b.st[0] = nloc; b.st[1] = nx; }
        const unsigned old = xb_add(&bar[XB_XSUB(b.x)], 1u);
        const unsigned gen = old / nloc;
        if (old + 1u == (gen + 1u) * nloc) {
            __builtin_amdgcn_fence(__ATOMIC_RELEASE, "agent");
            asm volatile("s_waitcnt vmcnt(0)" ::: "memory");
            const unsigned og = xb_add(&bar[XB_TOP], 1u);
            const unsigned tg = og / nx;
            if (og + 1u == (tg + 1u) * nx) xb_add(&bar[XB_TOPGEN], 1u);
            else XB_SPIN(xb_ld(&bar[XB_TOPGEN]) == tg, bar);
            __builtin_amdgcn_fence(__ATOMIC_ACQUIRE, "agent");
            xb_add(&bar[XB_XGEN(b.x)], 1u);
            asm volatile("s_waitcnt vmcnt(0)" ::: "memory");
        } else {
            XB_SPIN(xb_ld(&bar[XB_XGEN(b.x)]) == gen, bar);
            __builtin_amdgcn_fence(__ATOMIC_ACQUIRE, "agent");
            asm volatile("s_waitcnt vmcnt(0)" ::: "memory");
        }
    }
    __syncthreads();
}

constexpr size_t WS_CTL = 768 * 1024;
struct Args { const float* in[18]; float* out; unsigned char* ws; int ph_lo, ph_hi; };

__device__ __forceinline__ void attn_wave_unit(const bf16* UQK, const bf16* VT, bf16* MIXED, int b, int h, int qi, int lane) {
    const int r32 = lane & 31, hi = lane >> 5;
    const size_t tokb = (size_t)b * SEQ; const int t0 = qi * 32;
    const bf16* qp = UQK + (tokb + t0 + r32) * 1536 + 512 + h * 64 + 8 * hi;
    bf16x8 qf[4];
#pragma unroll
    for (int d = 0; d < 4; ++d) qf[d] = *(const bf16x8*)(qp + 16 * d);
    f32x16 o0, o1;
#pragma unroll
    for (int i = 0; i < 16; ++i) { o0[i] = 0.f; o1[i] = 0.f; }
    float carry = 0.f;
    const bf16* kbase = UQK + (tokb + r32) * 1536 + 1024 + h * 64 + 8 * hi;
    const bf16* vbase = VT + (size_t)(512 + h * 64 + r32) * MTOK + tokb + 4 * hi;
    for (int kb = qi; kb >= 0; --kb) {
        const int s0 = kb * 32;
        bf16x8 kf[4];
#pragma unroll
        for (int d = 0; d < 4; ++d) kf[d] = *(const bf16x8*)(kbase + (size_t)s0 * 1536 + 16 * d);
        s16x4 vt[2][2][2];
#pragma unroll
        for (int db = 0; db < 2; ++db)
#pragma unroll
            for (int j = 0; j < 2; ++j)
#pragma unroll
                for (int e = 0; e < 2; ++e) vt[db][j][e] = *(const s16x4*)(vbase + (size_t)db * 32 * MTOK + s0 + 16 * j + 8 * e);
        f32x16 z;
#pragma unroll
        for (int i = 0; i < 16; ++i) z[i] = 0.f;
#pragma unroll
        for (int d = 0; d < 4; ++d) z = __builtin_amdgcn_mfma_f32_32x32x16_bf16(kf[d], qf[d], z, 0, 0, 0);
        const bool diag = (kb == qi);
        float l[16];
#pragma unroll
        for (int i = 0; i < 16; ++i) { const float zz = z[i]; const float e = __builtin_amdgcn_exp2f(-fabsf(zz) * 1.4426950408889634f);
            const float sp = fmaxf(zz, 0.f) + 0.6931471805599453f * __builtin_amdgcn_logf(1.0f + e);
            const bool valid = !diag || (crow(i, hi) < r32); l[i] = valid ? -sp : 0.f; }
        float Gs[4], Go[4], T[4];
#pragma unroll
        for (int g = 0; g < 4; ++g) { Gs[g] = (l[4 * g] + l[4 * g + 1]) + (l[4 * g + 2] + l[4 * g + 3]); Go[g] = __shfl_xor(Gs[g], 32); T[g] = Gs[g] + Go[g]; }
        float aft[4]; aft[3] = 0.f; aft[2] = T[3]; aft[1] = T[3] + T[2]; aft[0] = aft[1] + T[1];
        const float total = aft[0] + T[0];
        float a[16];
#pragma unroll
        for (int g = 0; g < 4; ++g) { float run = aft[g] + (hi == 0 ? Go[g] : 0.f) + carry;
#pragma unroll
            for (int j = 3; j >= 0; --j) { const int i = 4 * g + j; run += l[i]; const bool valid = !diag || (crow(i, hi) < r32);
                a[i] = valid ? __builtin_amdgcn_exp2f((z[i] + run) * 1.4426950408889634f) : 0.f; } }
        carry += total;
        u32x4 p0, p1;
        p0.x = pk2(a[0], a[1]); p0.y = pk2(a[2], a[3]); p0.z = pk2(a[4], a[5]); p0.w = pk2(a[6], a[7]);
        p1.x = pk2(a[8], a[9]); p1.y = pk2(a[10], a[11]); p1.z = pk2(a[12], a[13]); p1.w = pk2(a[14], a[15]);
        const bf16x8 pb0 = __builtin_bit_cast(bf16x8, p0), pb1 = __builtin_bit_cast(bf16x8, p1);
#define VFRAG(db, j) (bf16x8){vt[db][j][0][0], vt[db][j][0][1], vt[db][j][0][2], vt[db][j][0][3], vt[db][j][1][0], vt[db][j][1][1], vt[db][j][1][2], vt[db][j][1][3]}
        o0 = __builtin_amdgcn_mfma_f32_32x32x16_bf16(VFRAG(0, 0), pb0, o0, 0, 0, 0);
        o0 = __builtin_amdgcn_mfma_f32_32x32x16_bf16(VFRAG(0, 1), pb1, o0, 0, 0, 0);
        o1 = __builtin_amdgcn_mfma_f32_32x32x16_bf16(VFRAG(1, 0), pb0, o1, 0, 0, 0);
        o1 = __builtin_amdgcn_mfma_f32_32x32x16_bf16(VFRAG(1, 1), pb1, o1, 0, 0, 0);
#undef VFRAG
        if (__all(carry < -40.0f)) break;
    }
    bf16* op = MIXED + (tokb + t0 + r32) * 1024 + 512 + h * 64 + 4 * hi;
#pragma unroll
    for (int g = 0; g < 4; ++g) {
        u32x2 w0; w0.x = pk2(o0[4 * g], o0[4 * g + 1]); w0.y = pk2(o0[4 * g + 2], o0[4 * g + 3]); *(u32x2*)(op + 8 * g) = w0;
        u32x2 w1; w1.x = pk2(o1[4 * g], o1[4 * g + 1]); w1.y = pk2(o1[4 * g + 2], o1[4 * g + 3]); *(u32x2*)(op + 32 + 8 * g) = w1; }
}

__device__ __forceinline__ void gmlp_unit(const bf16* UQK, const bf16* GVT, bf16* MIXED, const float* w_s, const float* b_s, const float* vgain, const float* ssgv, int b, int c, int h, int wave, int lane) {
    const int r32 = lane & 31, hi = lane >> 5, tb = wave >> 1, dbp = wave & 1;
    const size_t tokbase = (size_t)b * SEQ + (size_t)c * 128; const int t0 = 32 * tb, t = t0 + r32;
    const float* wrow = w_s + ((size_t)h * 128 + t) * 128 + 8 * hi;
    f32x16 acc0, acc1;
#pragma unroll
    for (int i = 0; i < 16; ++i) { acc0[i] = 0.f; acc1[i] = 0.f; }
    const int nks = 2 * (tb + 1);
    const bf16* g0p = GVT + (size_t)(h * 128 + 64 * dbp + r32) * MTOK + tokbase + 8 * hi;
    for (int ks = 0; ks < nks; ++ks) {
        const int s = 16 * ks + 8 * hi;
        const f32x4 w0 = *(const f32x4*)(wrow + 16 * ks), w1 = *(const f32x4*)(wrow + 16 * ks + 4);
        const f32x4 q0 = *(const f32x4*)(ssgv + tokbase + s), q1 = *(const f32x4*)(ssgv + tokbase + s + 4);
        float v[8];
#pragma unroll
        for (int e = 0; e < 4; ++e) { v[e] = (s + e <= t) ? w0[e] * pg8::rs_from_ss(q0[e], 1.0f / 512.0f) : 0.f; v[4 + e] = (s + 4 + e <= t) ? w1[e] * pg8::rs_from_ss(q1[e], 1.0f / 512.0f) : 0.f; }
        u32x4 bw; bw.x = pk2(v[0], v[1]); bw.y = pk2(v[2], v[3]); bw.z = pk2(v[4], v[5]); bw.w = pk2(v[6], v[7]);
        const bf16x8 bfrag = __builtin_bit_cast(bf16x8, bw);
        const bf16x8 a0 = *(const bf16x8*)(g0p + 16 * ks), a1 = *(const bf16x8*)(g0p + (size_t)32 * MTOK + 16 * ks);
        acc0 = __builtin_amdgcn_mfma_f32_32x32x16_bf16(a0, bfrag, acc0, 0, 0, 0);
        acc1 = __builtin_amdgcn_mfma_f32_32x32x16_bf16(a1, bfrag, acc1, 0, 0, 0);
    }
    const float bb = b_s[h * 128 + t];
    const size_t tok = tokbase + t;
#pragma unroll
    for (int dd = 0; dd < 2; ++dd)
#pragma unroll
        for (int g = 0; g < 4; ++g) { const int col = h * 128 + 64 * dbp + 32 * dd + 8 * g + 4 * hi;
            const u32x2 gu = *(const u32x2*)(UQK + tok * 1536 + col); const f32x4 vg = *(const f32x4*)(vgain + col);
            float c0, c1, c2, c3; if (dd == 0) { c0 = acc0[4 * g]; c1 = acc0[4 * g + 1]; c2 = acc0[4 * g + 2]; c3 = acc0[4 * g + 3]; } else { c0 = acc1[4 * g]; c1 = acc1[4 * g + 1]; c2 = acc1[4 * g + 2]; c3 = acc1[4 * g + 3]; }
            u32x2 w; w.x = pk2(pg8::bf_lo(gu.x) * (vg[0] * c0 + bb), pg8::bf_hi(gu.x) * (vg[1] * c1 + bb)); w.y = pk2(pg8::bf_lo(gu.y) * (vg[2] * c2 + bb), pg8::bf_hi(gu.y) * (vg[3] * c3 + bb));
            *(u32x2*)(MIXED + tok * 1024 + col) = w; }
}

__global__ void __launch_bounds__(NWAVES * 64, 2) mk_fwd(Args args) {
    extern __shared__ __attribute__((aligned(16))) unsigned char lds_raw[];
    LAS unsigned char* lds = (LAS unsigned char*)lds_raw;
    const int tid = threadIdx.x, lane = tid & 63, wave = __builtin_amdgcn_readfirstlane(tid >> 6);
    const int G = gridDim.x, bx = blockIdx.x;
    const int gw = bx * NWAVES + wave, NGW = G * NWAVES;
#define ws (args.ws)
#define xin (args.in[0])
#define pin (args.in[1])
#define ssx ((float*)(ws + WS_SS))
#define ss1 (ssx + MTOK)
#define ssgv (ssx + 2 * MTOK)
#define ss2 (ssx + 3 * MTOK)
#define ss3 (ssx + 4 * MTOK)
#define ss4 (ssx + 5 * MTOK)
#define W1in ((bf16*)(ws + WS_W1IN))
#define W1out ((bf16*)(ws + WS_W1OUT))
#define Wmix ((bf16*)(ws + WS_WMIX))
#define Wmo ((bf16*)(ws + WS_WMO))
#define W2in ((bf16*)(ws + WS_W2IN))
#define W2out ((bf16*)(ws + WS_W2OUT))
#define Wg ((bf16*)(ws + WS_WG))
#define Wp ((bf16*)(ws + WS_WP))
#define HB ((bf16*)(ws + WS_HB))
#define MIXED ((bf16*)(ws + WS_MIXED))
#define PB ((bf16*)(ws + WS_PB))
#define HID ((bf16*)(ws + WS_BIG))
#define UQK ((bf16*)(ws + WS_BIG))
#define GVT ((bf16*)(ws + WS_GVT))
#define SLAB ((u32x4*)(ws + WS_BIG))
#define out (args.out)
    const int lo = args.ph_lo, hi_ph = args.ph_hi;
#ifndef PHASE_MASK
#define PHASE_MASK 0x3ff
#endif
#define IN(k) (((PHASE_MASK >> (k)) & 1) && lo <= (k) && (k) < hi_ph)
#define SEAM(k) do { if (IN(k) && IN((k) + 1)) { if ((k) == 0) cg::this_grid().sync(); else xcd_barrier(bar); } } while (0)
    if (tid < 2) ((LAS unsigned*)(lds + RING_BYTES))[tid] = 0u;
    __syncthreads();
    XcdBarrier bar = xcd_barrier_post((unsigned*)(ws + WS_CTL), (volatile LAS unsigned*)(lds + RING_BYTES));

    if (IN(0)) {
        LAS float* scr = (LAS float*)(lds + wave * 16384);
        constexpr int I_IN = (DM / 64) * (2 * DFF / 32), I_OUT = (DFF / 64) * (DM / 32), I_MIX = (DM / 64) * (2560 / 32), I_SQ = (DM / 64) * (DM / 32), I_P = (PLE / 64) * (DM / 32);
        constexpr int NITEMS = 2 * I_IN + 2 * I_OUT + I_MIX + 2 * I_SQ + I_P;
        for (int it = gw; it < NITEMS; it += NGW) {
            int r = it;
            if (r < I_IN) { p0_transpose_item(args.in[3], DM, 2 * DFF, W1in, args.in[2], 1, scr, r, lane); continue; } r -= I_IN;
            if (r < I_IN) { p0_transpose_item(args.in[12], DM, 2 * DFF, W2in, args.in[11], 1, scr, r, lane); continue; } r -= I_IN;
            if (r < I_OUT) { p0_transpose_item(args.in[4], DFF, DM, W1out, nullptr, 0, scr, r, lane); continue; } r -= I_OUT;
            if (r < I_OUT) { p0_transpose_item(args.in[13], DFF, DM, W2out, nullptr, 0, scr, r, lane); continue; } r -= I_OUT;
            if (r < I_MIX) { p0_transpose_item(args.in[6], DM, 2560, Wmix, args.in[5], 2, scr, r, lane); continue; } r -= I_MIX;
            if (r < I_SQ) { p0_transpose_item(args.in[10], DM, DM, Wmo, nullptr, 0, scr, r, lane); continue; } r -= I_SQ;
            if (r < I_SQ) { p0_transpose_item(args.in[15], DM, DM, Wg, args.in[14], 0, scr, r, lane); continue; } r -= I_SQ;
            p0_transpose_item(args.in[16], PLE, DM, Wp, nullptr, 0, scr, r, lane);
        }
        for (int m = gw; m < MTOK; m += NGW) {
            const f32x4* xr = (const f32x4*)(xin + (size_t)m * DM) + lane; f32x4 v[4]; float s = 0.f;
#pragma unroll
            for (int j = 0; j < 4; ++j) { v[j] = xr[64 * j]; s += (v[j][0] * v[j][0] + v[j][1] * v[j][1]) + (v[j][2] * v[j][2] + v[j][3] * v[j][3]); }
            s = wave_sum(s); if (lane == 0) ssx[m] = s;
            u32x2* o8 = (u32x2*)(HB + (size_t)m * DM) + lane;
#pragma unroll
            for (int j = 0; j < 4; ++j) { u32x2 w; w.x = pk2(v[j][0], v[j][1]); w.y = pk2(v[j][2], v[j][3]); o8[64 * j] = w; }
        }
        for (size_t i = (size_t)gw * 64 + lane; i < (size_t)MTOK * PLE / 8; i += (size_t)NGW * 64) {
            const f32x4 a = ((const f32x4*)pin)[2 * i], b = ((const f32x4*)pin)[2 * i + 1];
            u32x4 w; w.x = pk2(a[0], a[1]); w.y = pk2(a[2], a[3]); w.z = pk2(b[0], b[1]); w.w = pk2(b[2], b[3]); ((u32x4*)PB)[i] = w;
        }
        for (int i = gw * 64 + lane; i < 5 * MTOK; i += NGW * 64) ss1[i] = 0.f;
    }
    SEAM(0);
    if (IN(1)) {
        pg8::Gemm g{HB, W1in, MTOK, 2 * DFF, DM}; pg8::StaticOrder S; S.init(MTOK, 2 * DFF, G, bx);
        pg8::EpiSwiGLU E{HID, DFF, ssx};
        pg8::gemm_phase<pg8::EpiSwiGLU, pg8::StaticOrder, true, true>(lds, g, S, E);
    }
    SEAM(1);
    if (IN(2)) {
        pg8::Gemm g{HID, W1out, MTOK, DM, DFF}; pg8::StaticOrder S; S.init(MTOK, DM, G, bx);
        pg8::EpiResid E{xin, out, HB, ss1, 0.5f, DM};
        pg8::gemm_phase<pg8::EpiResid, pg8::StaticOrder, true, true>(lds, g, S, E);
    }
    SEAM(2);
    if (IN(3)) {
        { pg8::Gemm g{HB, Wmix, MTOK, 1536, DM}; pg8::StaticOrder S; S.init(MTOK, 1536, G, bx);
          pg8::EpiMixTok E{UQK, 1536, ss1};
          pg8::gemm_phase<pg8::EpiMixTok, pg8::StaticOrder, true, true>(lds, g, S, E); }
        { pg8::Gemm g{Wmix + (size_t)1536 * DM, HB, 1024, MTOK, DM}; pg8::StaticOrder S; S.init(1024, MTOK, G, bx);
          pg8::EpiMixT E{GVT, MTOK, ss1, ssgv};
          pg8::gemm_phase<pg8::EpiMixT, pg8::StaticOrder, true, true>(lds, g, S, E); }
    }
    SEAM(3);
    if (IN(4)) {
        for (int u = bx; u < BATCH * 32 * 4; u += G) { const int h = u & 3, c = (u >> 2) & 31, b = u >> 7;
            gmlp_unit(UQK, GVT, MIXED, args.in[8], args.in[9], args.in[7], ssgv, b, c, h, wave, lane); }
        for (int u = gw; u < BATCH * 8 * (SEQ / 32); u += NGW) { const int qi = u & 127, h = (u >> 7) & 7, b = u >> 10;
            attn_wave_unit(UQK, GVT, MIXED, b, h, qi, lane); }
    }
    SEAM(4);
    if (IN(5)) {
        pg8::Gemm g{MIXED, Wmo, MTOK, DM, DM}; pg8::StaticOrder S; S.init(MTOK, DM, G, bx);
        pg8::EpiResid E{out, out, HB, ss2, 1.0f, DM};
        pg8::gemm_phase<pg8::EpiResid, pg8::StaticOrder, true, true>(lds, g, S, E);
    }
    SEAM(5);
    if (IN(6)) {
        pg8::Gemm g{HB, W2in, MTOK, 2 * DFF, DM}; pg8::StaticOrder S; S.init(MTOK, 2 * DFF, G, bx);
        pg8::EpiSwiGLU E{HID, DFF, ss2};
        pg8::gemm_phase<pg8::EpiSwiGLU, pg8::StaticOrder, true, true>(lds, g, S, E);
    }
    SEAM(6);
    if (IN(7)) {
        pg8::Gemm g{HID, W2out, MTOK, DM, DFF}; pg8::StaticOrder S; S.init(MTOK, DM, G, bx);
        pg8::EpiResid E{out, out, HB, ss3, 0.5f, DM};
        pg8::gemm_phase<pg8::EpiResid, pg8::StaticOrder, true, true>(lds, g, S, E);
    }
    SEAM(7);
    if (IN(8)) {
#ifndef P8_NO_PP
        { pg8::Gemm g{PB, Wp, MTOK, DM, PLE}; pg8::StaticOrder S; S.init(MTOK, DM, G, bx);
          pg8::EpiPP E{SLAB};
          pg8::gemm_phase<pg8::EpiPP, pg8::StaticOrder, true, true>(lds, g, S, E); }
#endif
        asm volatile("s_waitcnt vmcnt(0)" ::: "memory");
#ifndef P8_NO_GATE
        { pg8::Gemm g{HB, Wg, MTOK, DM, DM}; pg8::StaticOrder S; S.init(MTOK, DM, G, bx);
          pg8::EpiGate E{out, out, SLAB, ss3, ss4, DM};
          pg8::gemm_phase<pg8::EpiGate, pg8::StaticOrder, true, true>(lds, g, S, E); }
#endif
    }
    SEAM(8);
    if (IN(9)) {
        const f32x4* gf = (const f32x4*)args.in[17] + lane; f32x4 gv[4];
#pragma unroll
        for (int j = 0; j < 4; ++j) gv[j] = gf[64 * j];
        for (int m = gw; m < MTOK; m += NGW) {
            f32x4* xr = (f32x4*)(out + (size_t)m * DM) + lane; const float r = pg8::rs_from_ss(ss4[m], 1.0f / 1024.0f);
#pragma unroll
            for (int j = 0; j < 4; ++j) xr[64 * j] = xr[64 * j] * r * gv[j];
        }
    }
#undef IN
#undef SEAM
#undef ws
#undef xin
#undef pin
#undef ssx
#undef ss1
#undef ssgv
#undef ss2
#undef ss3
#undef ss4
#undef W1in
#undef W1out
#undef Wmix
#undef Wmo
#undef W2in
#undef W2out
#undef Wg
#undef Wp
#undef HB
#undef MIXED
#undef PB
#undef HID
#undef UQK
#undef GVT
#undef SLAB
#undef out
}

extern "C" void kernel_launch(void* const* d_in, const int* in_sizes, int n_in, void* d_out, int out_size, void* d_ws, size_t ws_size, hipStream_t stream) {
    static int grid = 0;
    if (grid == 0) {
        if (n_in != 18 || out_size != MTOK * DM || ws_size < WS_END) { fprintf(stderr, "kernel_launch: unexpected shapes (n_in %d out %d ws %zu)\n", n_in, out_size, ws_size); grid = -1; return; }
        int dev = 0, cus = 0, per_cu = 0;
        hipGetDevice(&dev); hipDeviceGetAttribute(&cus, hipDeviceAttributeMultiprocessorCount, dev);
        hipFuncSetAttribute((const void*)mk_fwd, hipFuncAttributeMaxDynamicSharedMemorySize, LDS_BYTES);
        hipOccupancyMaxActiveBlocksPerMultiprocessor(&per_cu, (const void*)mk_fwd, NWAVES * 64, LDS_BYTES);
        if (per_cu < 1) { fprintf(stderr, "kernel_launch: occupancy query says %d blocks per CU\n", per_cu); per_cu = 1; }
        (void)hipGetLastError();
        grid = cus * per_cu;
    }
    if (grid < 0) return;
    Args a{};
    for (int i = 0; i < 18; ++i) a.in[i] = (const float*)d_in[i];
    a.out = (float*)d_out; a.ws = (unsigned char*)d_ws;
    (void)hipMemsetAsync((char*)d_ws + WS_CTL, 0, 16384, stream);
#if MK_N_LAUNCHES == 1
    a.ph_lo = 0; a.ph_hi = NPHASE;
    void* kargs[] = {&a};
    hipError_t e = hipLaunchCooperativeKernel((const void*)mk_fwd, dim3(grid), dim3(NWAVES * 64), kargs, LDS_BYTES, stream);
    if (e != hipSuccess) fprintf(stderr, "cooperative launch failed: %s (grid %d)\n", hipGetErrorString(e), grid);
#else
    for (int ph = 0; ph < NPHASE; ++ph) { a.ph_lo = ph; a.ph_hi = ph + 1; hipLaunchKernelGGL(mk_fwd, dim3(grid), dim3(NWAVES * 64), LDS_BYTES, stream, a); }
#endif
}
```

```cpp
#include <hip/hip_runtime.h>
#include <cstdio>
#include <cstdint>
#define MK_N_LAUNCHES 1
namespace pg8 {
#define PG8_LAS __attribute__((address_space(3)))
typedef unsigned short bf16_t;
typedef short bf16x8 __attribute__((ext_vector_type(8)));
typedef float f32x4 __attribute__((ext_vector_type(4)));
typedef unsigned u32x4 __attribute__((ext_vector_type(4)));
constexpr int BM = 256, BK = 64, HALF = 128, HTB = HALF * BK * 2  , STAGE_BYTES = 8 * HTB, NXCD = 8, WGM = 8;

__host__ __device__ __forceinline__ int lds_byte(int r, int c) { const int st = (r >> 4) * 2 + (c >> 5), rr = r & 15, cc = c & 31, ob = rr * 64 + cc * 2; return st * 1024 + (ob ^ (((ob >> 9) & 1) << 5)); }
__host__ __device__ __forceinline__ void stage_rc(int b, int& R, int& C) { const int st = b / 1024, sb = b % 1024, swz = sb ^ (((sb >> 9) & 1) << 5); R = (st >> 1) * 16 + swz / 64; C = (st & 1) * 32 + (swz % 64) / 2; }
__host__ __device__ __forceinline__ int perm32(int rho) { const int n = rho >> 4, i = rho & 15; return 8 * (i >> 2) + 4 * n + (i & 3); }

struct Unit { int pm, pn; };
struct Gemm { const bf16_t* A; const bf16_t* Bt; int M, N, K; };

struct StaticOrder {
    int nM, nN, nwg, G, c, wgm;
    __host__ __device__ void init(int M, int N, int G_, int c_, int wgm_ = WGM) { nM = M / BM; nN = N / BM; nwg = nM * nN; G = G_; c = c_; wgm = wgm_; }
    __host__ __device__ bool next(int i, Unit& u) const {
        const long L = (long)i * G + c; if (L >= nwg) return false;
        int wgid = (int)L; { const int q = nwg / NXCD, r = nwg % NXCD, xcd = wgid % NXCD, off = wgid / NXCD; wgid = (xcd < r ? xcd * (q + 1) : r * (q + 1) + (xcd - r) * q) + off; }
        const int nig = wgm * nN, gid = wgid / nig, fm = gid * wgm, gsz = (nM - fm) < wgm ? (nM - fm) : wgm;
        u.pm = fm + ((wgid % nig) % gsz); u.pn = (wgid % nig) / gsz; return true;
    }
    __device__ __forceinline__ void a_ready(const Unit&) const {}
    __device__ __forceinline__ void done(const Unit&) const {}
};

__device__ __forceinline__ unsigned cvt_pk_bf16(float lo, float hi) { unsigned r; asm volatile("v_cvt_pk_bf16_f32 %0, %1, %2" : "=v"(r) : "v"(lo), "v"(hi)); return r; }
typedef float f32x2 __attribute__((ext_vector_type(2)));
__device__ __forceinline__ f32x2 gelu_pk(f32x2 v) {
    const f32x2 av = __builtin_elementwise_abs(v), d = av * 0.2316418882f + 1.0f;
    f32x2 t; t.x = __builtin_amdgcn_rcpf(d.x); t.y = __builtin_amdgcn_rcpf(d.y);
    f32x2 q = t * 0.5307027145f + (-0.7265760135f); q = q * t + 0.7107068705f; q = q * t + (-0.142248368f); q = q * t + 0.127414796f; q = q * t;
    const f32x2 s = (v * v) * (-0.72134752044f);
    f32x2 e; e.x = __builtin_amdgcn_exp2f(s.x); e.y = __builtin_amdgcn_exp2f(s.y);
    const f32x2 m = v * (q * e), r = v - m;
    f32x2 o; o.x = v.x < 0.f ? m.x : r.x; o.y = v.y < 0.f ? m.y : r.y; return o;
}


constexpr float RMS_EPS = 1e-6f;
__device__ __forceinline__ float rs_from_ss(float ss, float inv_n) { return __builtin_amdgcn_rsqf(ss * inv_n + RMS_EPS); }
__device__ __forceinline__ float silu_f(float g) { return g * __builtin_amdgcn_rcpf(1.0f + __builtin_amdgcn_exp2f(g * -1.4426950408889634f)); }
__device__ __forceinline__ float sigmoid_f(float g) { return __builtin_amdgcn_rcpf(1.0f + __builtin_amdgcn_exp2f(g * -1.4426950408889634f)); }
typedef unsigned u32x2 __attribute__((ext_vector_type(2)));

struct PreF8 { float v[8]; };
struct PreNone { int dummy; };
struct EpiSwiGLU {
    typedef PreF8 Pre;
    static constexpr bool PERM = true, AFTER_DRAIN = false, RS_PREFETCH = true, WIDE = false;
    bf16_t* O; int ldc; const float* ss;
    __device__ __forceinline__ void load_rs(PreF8& rs, const Unit& u, int wr, int wc, int fr, int fq) const {
#pragma unroll
        for (int j = 0; j < 8; ++j) rs.v[j] = ss[u.pm * BM + wr * 64 + fr + (j >> 2) * HALF + (j & 3) * 16];
    }
    __device__ __forceinline__ void operator()(const f32x4 (&acc)[2][2][4][2], const Unit& u, int wr, int wc, int fr, int fq, const PreF8& rs) const {
        const int row0 = u.pm * BM + wr * 64 + fr; const int col0 = u.pn * HALF + wc * 32 + 8 * fq;
#pragma unroll
        for (int ai = 0; ai < 2; ++ai)
#pragma unroll
            for (int m = 0; m < 4; ++m) { const int row = row0 + ai * HALF + m * 16; const float r = rs_from_ss(rs.v[ai * 4 + m], 1.0f / 1024.0f);
                const float c1 = r * -1.4426950408889634f, r2 = r * r;
                const f32x4 g0 = acc[ai][0][m][0], g1 = acc[ai][0][m][1], u0 = acc[ai][1][m][0], u1 = acc[ai][1][m][1];
                f32x4 t0 = g0 * u0, t1 = g1 * u1, e0 = g0 * c1, e1 = g1 * c1, s0, s1;
#pragma unroll
                for (int i = 0; i < 4; ++i) { s0[i] = __builtin_amdgcn_rcpf(1.0f + __builtin_amdgcn_exp2f(e0[i])); s1[i] = __builtin_amdgcn_rcpf(1.0f + __builtin_amdgcn_exp2f(e1[i])); }
                t0 = t0 * (s0 * r2); t1 = t1 * (s1 * r2);
                u32x4 w; w.x = cvt_pk_bf16(t0[0], t0[1]); w.y = cvt_pk_bf16(t0[2], t0[3]); w.z = cvt_pk_bf16(t1[0], t1[1]); w.w = cvt_pk_bf16(t1[2], t1[3]);
                __builtin_nontemporal_store(w, (u32x4*)(O + (size_t)row * ldc + col0)); }
    }
};

struct EpiResidX {
    typedef PreNone Pre;
    static constexpr bool PERM = true, AFTER_DRAIN = false, RS_PREFETCH = false, WIDE = false;
    const float* res; bf16_t* ob; float* ssout; float alpha; int ldc;
    __device__ __forceinline__ void operator()(const f32x4 (&acc)[2][2][4][2], const Unit& u, int wr, int wc, int fr, int fq) const {
        const int row0 = u.pm * BM + wr * 64 + fr, col0 = u.pn * BM + wc * 32 + 8 * fq;
#pragma unroll
        for (int ai = 0; ai < 2; ++ai) {
            f32x4 rv[4][2][2];
#pragma unroll
            for (int m = 0; m < 4; ++m)
#pragma unroll
                for (int bj = 0; bj < 2; ++bj)
#pragma unroll
                    for (int n = 0; n < 2; ++n) rv[m][bj][n] = *(const f32x4*)(res + (size_t)(row0 + ai * HALF + m * 16) * ldc + col0 + bj * HALF + n * 4);
#pragma unroll
            for (int m = 0; m < 4; ++m) { const int row = row0 + ai * HALF + m * 16; const size_t off = (size_t)row * ldc + col0; float sq = 0.f;
#pragma unroll
                for (int bj = 0; bj < 2; ++bj) { const f32x4 o0 = rv[m][bj][0] + acc[ai][bj][m][0] * alpha, o1 = rv[m][bj][1] + acc[ai][bj][m][1] * alpha;
                    sq += ((o0[0] * o0[0] + o0[1] * o0[1]) + (o0[2] * o0[2] + o0[3] * o0[3])) + ((o1[0] * o1[0] + o1[1] * o1[1]) + (o1[2] * o1[2] + o1[3] * o1[3]));
                    u32x4 w; w.x = cvt_pk_bf16(o0[0], o0[1]); w.y = cvt_pk_bf16(o0[2], o0[3]); w.z = cvt_pk_bf16(o1[0], o1[1]); w.w = cvt_pk_bf16(o1[2], o1[3]); *(u32x4*)(ob + off + bj * HALF) = w; }
                sq += __shfl_xor(sq, 16); sq += __shfl_xor(sq, 32);
                if (fq == 0) atomicAdd(ssout + row, sq); }
            asm volatile("" ::: "memory"); }
    }
};
__device__ __forceinline__ float bf_lo(unsigned w) { return __uint_as_float(w << 16); }
__device__ __forceinline__ float bf_hi(unsigned w) { return __uint_as_float(w & 0xffff0000u); }
#ifdef PROBE_A
#define EPI_STAMP(T) do { if (blockIdx.x == 0 && threadIdx.x == 0) { unsigned long long* T_ = (unsigned long long*)(T); const unsigned k_ = (unsigned)T_[63]; T_[32 + k_] = __builtin_amdgcn_s_memrealtime(); T_[63] = k_ + 1; } } while (0)
#else
#define EPI_STAMP(T) do {} while (0)
#endif
struct PreRes { u32x4 v[6]; };
struct EpiResidB {
    typedef PreRes Pre;
    static constexpr bool PERM = true, AFTER_DRAIN = false, RS_PREFETCH = true, WIDE = true;
    static constexpr int NPRE = 6;
    bf16_t* hb; float* ssout; float alpha; int ldc; void* tsb;
    __device__ __forceinline__ void load_rs(PreRes& pre, const Unit& u, int wr, int wc, int fr, int fq) const {
        const int row0 = u.pm * BM + wr * 64 + fr, col0 = u.pn * BM + wc * 64 + 8 * fq;
#pragma unroll
        for (int j = 0; j < NPRE; ++j) { const int ai = j >> 3, m = (j >> 1) & 3, bj = j & 1; pre.v[j] = *(const u32x4*)(hb + (size_t)(row0 + ai * HALF + m * 16) * ldc + col0 + bj * 32); }
    }
    __device__ __forceinline__ void operator()(const f32x4 (&acc)[2][2][4][2], const Unit& u, int wr, int wc, int fr, int fq, const PreRes& pre) const {
        EPI_STAMP(tsb);
        const int row0 = u.pm * BM + wr * 64 + fr, col0 = u.pn * BM + wc * 64 + 8 * fq;
        u32x4 rv[2][4][2];
#pragma unroll
        for (int ai = 0; ai < 2; ++ai)
#pragma unroll
            for (int m = 0; m < 4; ++m)
#pragma unroll
                for (int bj = 0; bj < 2; ++bj) { const int j = ai * 8 + m * 2 + bj;
                    if (j < NPRE) rv[ai][m][bj] = pre.v[j < NPRE ? j : 0]; else rv[ai][m][bj] = *(const u32x4*)(hb + (size_t)(row0 + ai * HALF + m * 16) * ldc + col0 + bj * 32); }
#pragma unroll
        for (int ai = 0; ai < 2; ++ai)
#pragma unroll
            for (int m = 0; m < 4; ++m) { const int row = row0 + ai * HALF + m * 16; const size_t off = (size_t)row * ldc + col0; float sq = 0.f;
#pragma unroll
                for (int bj = 0; bj < 2; ++bj) { const u32x4 rw = rv[ai][m][bj];
                    const f32x4 o0 = (f32x4){bf_lo(rw.x), bf_hi(rw.x), bf_lo(rw.y), bf_hi(rw.y)} + acc[ai][bj][m][0] * alpha, o1 = (f32x4){bf_lo(rw.z), bf_hi(rw.z), bf_lo(rw.w), bf_hi(rw.w)} + acc[ai][bj][m][1] * alpha;
                    sq += ((o0[0] * o0[0] + o0[1] * o0[1]) + (o0[2] * o0[2] + o0[3] * o0[3])) + ((o1[0] * o1[0] + o1[1] * o1[1]) + (o1[2] * o1[2] + o1[3] * o1[3]));
                    u32x4 w; w.x = cvt_pk_bf16(o0[0], o0[1]); w.y = cvt_pk_bf16(o0[2], o0[3]); w.z = cvt_pk_bf16(o1[0], o1[1]); w.w = cvt_pk_bf16(o1[2], o1[3]); *(u32x4*)(hb + off + bj * 32) = w; }
                sq += __shfl_xor(sq, 16); sq += __shfl_xor(sq, 32);
                if (fq == 0) atomicAdd(ssout + row, sq); }
        EPI_STAMP(tsb);
    }
};

struct EpiMixTok {
    typedef PreF8 Pre;
    static constexpr bool PERM = true, AFTER_DRAIN = false, RS_PREFETCH = true, WIDE = true;
    bf16_t* O; int ldc; const float* ss;
    __device__ __forceinline__ void load_rs(PreF8& rs, const Unit& u, int wr, int wc, int fr, int fq) const {
#pragma unroll
        for (int j = 0; j < 8; ++j) rs.v[j] = ss[u.pm * BM + wr * 64 + fr + (j >> 2) * HALF + (j & 3) * 16];
    }
    __device__ __forceinline__ void operator()(const f32x4 (&acc)[2][2][4][2], const Unit& u, int wr, int wc, int fr, int fq, const PreF8& rs) const {
        const int row0 = u.pm * BM + wr * 64 + fr; const int col0 = u.pn * BM + wc * 64 + 8 * fq;
        const bool isu = u.pn < 2; const float sc = (u.pn == 2 || u.pn == 3) ? 0.125f : 1.0f;
#pragma unroll
        for (int ai = 0; ai < 2; ++ai)
#pragma unroll
            for (int m = 0; m < 4; ++m) { const int row = row0 + ai * HALF + m * 16; const float r = rs_from_ss(rs.v[ai * 4 + m], 1.0f / 1024.0f) * sc;
#pragma unroll
                for (int bj = 0; bj < 2; ++bj) { f32x4 v0 = acc[ai][bj][m][0] * r, v1 = acc[ai][bj][m][1] * r;
                    if (isu) { const f32x2 a = gelu_pk((f32x2){v0[0], v0[1]}), b = gelu_pk((f32x2){v0[2], v0[3]}), c = gelu_pk((f32x2){v1[0], v1[1]}), d = gelu_pk((f32x2){v1[2], v1[3]});
                        v0 = (f32x4){a.x, a.y, b.x, b.y}; v1 = (f32x4){c.x, c.y, d.x, d.y}; }
                    u32x4 w; w.x = cvt_pk_bf16(v0[0], v0[1]); w.y = cvt_pk_bf16(v0[2], v0[3]); w.z = cvt_pk_bf16(v1[0], v1[1]); w.w = cvt_pk_bf16(v1[2], v1[3]);
                    *(u32x4*)(O + (size_t)row * ldc + col0 + bj * 32) = w; } }
    }
};

struct EpiMixT {
    typedef PreNone Pre;
    static constexpr bool PERM = true, AFTER_DRAIN = false, RS_PREFETCH = false, WIDE = true;
    bf16_t* GT; bf16_t* VT; const float* ss; float* ssgv;
    __device__ __forceinline__ void operator()(const f32x4 (&acc)[2][2][4][2], const Unit& u, int wr, int wc, int fr, int fq) const {
        const int row0 = u.pm * BM + wr * 64 + fr; const int col0 = u.pn * BM + wc * 64 + 8 * fq;
        const bool isg = u.pm < 2;
        f32x4 rt[2][2], cs[2][2];
#pragma unroll
        for (int bj = 0; bj < 2; ++bj)
#pragma unroll
            for (int n = 0; n < 2; ++n) { const f32x4 s = *(const f32x4*)(ss + col0 + bj * 32 + 4 * n);
                rt[bj][n] = (f32x4){rs_from_ss(s[0], 1.0f / 1024.0f), rs_from_ss(s[1], 1.0f / 1024.0f), rs_from_ss(s[2], 1.0f / 1024.0f), rs_from_ss(s[3], 1.0f / 1024.0f)};
                cs[bj][n] = (f32x4){0.f, 0.f, 0.f, 0.f}; }
#pragma unroll
        for (int ai = 0; ai < 2; ++ai)
#pragma unroll
            for (int m = 0; m < 4; ++m) { const int c = row0 + ai * HALF + m * 16;
#pragma unroll
                for (int bj = 0; bj < 2; ++bj) { f32x4 v0 = acc[ai][bj][m][0] * rt[bj][0], v1 = acc[ai][bj][m][1] * rt[bj][1];
                    const int tok0 = col0 + bj * 32;
                    if (isg) { const f32x2 a = gelu_pk((f32x2){v0[0], v0[1]}), b = gelu_pk((f32x2){v0[2], v0[3]}), cc = gelu_pk((f32x2){v1[0], v1[1]}), d = gelu_pk((f32x2){v1[2], v1[3]});
                        v0 = (f32x4){a.x, a.y, b.x, b.y}; v1 = (f32x4){cc.x, cc.y, d.x, d.y}; cs[bj][0] += v0 * v0; cs[bj][1] += v1 * v1; }
                    u32x4 w; w.x = cvt_pk_bf16(v0[0], v0[1]); w.y = cvt_pk_bf16(v0[2], v0[3]); w.z = cvt_pk_bf16(v1[0], v1[1]); w.w = cvt_pk_bf16(v1[2], v1[3]);
                    if (isg) { const int h = c >> 7, d = c & 127, sl = tok0 & 127;
                        *(u32x4*)(GT + ((((size_t)((tok0 >> 7) * 4 + h) * 32 + (d >> 5) * 8 + (sl >> 4)) * 64) + ((sl >> 3) & 1) * 32 + (d & 31)) * 8) = w; }
                    else { const int c2 = c - 512, h = c2 >> 6, d = c2 & 63, sl = tok0 & 31, q = sl >> 3;
                        bf16_t* tp = VT + ((((size_t)(h * 1024 + (tok0 >> 5)) * 4 + (d >> 5) * 2 + (q >> 1)) * 64) + (d & 31)) * 8 + (q & 1) * 4;
                        u32x2 lo2; lo2.x = w.x; lo2.y = w.y; u32x2 hi2; hi2.x = w.z; hi2.y = w.w;
                        *(u32x2*)tp = lo2; *(u32x2*)(tp + 32 * 8) = hi2; } } }
        if (isg) {
            float mine = 0.f;
#pragma unroll
            for (int bj = 0; bj < 2; ++bj)
#pragma unroll
                for (int n = 0; n < 2; ++n)
#pragma unroll
                    for (int i = 0; i < 4; ++i) { float v = cs[bj][n][i]; v += __shfl_xor(v, 1); v += __shfl_xor(v, 2); v += __shfl_xor(v, 4); v += __shfl_xor(v, 8);
                        mine = (fr == bj * 8 + n * 4 + i) ? v : mine; }
            const int tok = col0 + (fr >> 3) * 32 + (fr & 7);
            atomicAdd(ssgv + tok, mine);
        }
    }
};

struct EpiPP {
    typedef PreNone Pre;
    static constexpr bool PERM = true, AFTER_DRAIN = false, RS_PREFETCH = false, WIDE = true;
    u32x4* slab;
    __device__ __forceinline__ void operator()(const f32x4 (&acc)[2][2][4][2], const Unit& u, int wr, int wc, int fr, int fq) const {
        u32x4* p = slab + (size_t)(u.pm * 4 + u.pn) * 16 * 512 + threadIdx.x;
#pragma unroll
        for (int ai = 0; ai < 2; ++ai)
#pragma unroll
            for (int bj = 0; bj < 2; ++bj)
#pragma unroll
                for (int m = 0; m < 4; ++m) { const f32x4 v0 = acc[ai][bj][m][0], v1 = acc[ai][bj][m][1];
                    u32x4 w; w.x = cvt_pk_bf16(v0[0], v0[1]); w.y = cvt_pk_bf16(v0[2], v0[3]); w.z = cvt_pk_bf16(v1[0], v1[1]); w.w = cvt_pk_bf16(v1[2], v1[3]);
                    p[(size_t)((ai * 2 + bj) * 4 + m) * 512] = w; }
    }
};
struct EpiGate {
    typedef PreNone Pre;
    static constexpr bool PERM = true, AFTER_DRAIN = false, RS_PREFETCH = false, WIDE = true;
    const bf16_t* hb; float* out; const u32x4* slab; const float* ss; float* ssout; unsigned* cnt; const float* gfin; int ldc; void* tsb;
    __device__ __forceinline__ void operator()(f32x4 (&acc)[2][2][4][2], const Unit& u, int wr, int wc, int fr, int fq) const {
        const int row0 = u.pm * BM + wr * 64 + fr, col0 = u.pn * BM + wc * 64 + 8 * fq;
        const u32x4* p = slab + (size_t)(u.pm * 4 + u.pn) * 16 * 512 + threadIdx.x;
#pragma unroll
        for (int ai = 0; ai < 2; ++ai) {
            u32x4 rv[4][2]; u32x4 pw[4][2]; float rr[4];
#pragma unroll
            for (int m = 0; m < 4; ++m) { rr[m] = ss[row0 + ai * HALF + m * 16];
#pragma unroll
                for (int bj = 0; bj < 2; ++bj) { pw[m][bj] = p[(size_t)((ai * 2 + bj) * 4 + m) * 512];
                    rv[m][bj] = *(const u32x4*)(hb + (size_t)(row0 + ai * HALF + m * 16) * ldc + col0 + bj * 32); } }
#pragma unroll
            for (int m = 0; m < 4; ++m) { const int row = row0 + ai * HALF + m * 16; float sq = 0.f;
                const float r = rs_from_ss(rr[m], 1.0f / 1024.0f);
#pragma unroll
                for (int bj = 0; bj < 2; ++bj) { const u32x4 pq = pw[m][bj], rw = rv[m][bj];
#pragma unroll
                    for (int n = 0; n < 2; ++n) { const unsigned p0 = n ? pq.z : pq.x, p1 = n ? pq.w : pq.y, r0 = n ? rw.z : rw.x, r1 = n ? rw.w : rw.y;
                        const f32x4 a = acc[ai][bj][m][n] * r;
                        f32x4 o; o[0] = bf_lo(r0) + sigmoid_f(a[0]) * bf_lo(p0); o[1] = bf_hi(r0) + sigmoid_f(a[1]) * bf_hi(p0); o[2] = bf_lo(r1) + sigmoid_f(a[2]) * bf_lo(p1); o[3] = bf_hi(r1) + sigmoid_f(a[3]) * bf_hi(p1);
                        acc[ai][bj][m][n] = o; sq += (o[0] * o[0] + o[1] * o[1]) + (o[2] * o[2] + o[3] * o[3]); } }
                sq += __shfl_xor(sq, 16); sq += __shfl_xor(sq, 32);
                if (fq == 0) __hip_atomic_fetch_add(ssout + row, sq, __ATOMIC_RELAXED, __HIP_MEMORY_SCOPE_AGENT); }
            asm volatile("" ::: "memory"); }
        asm volatile("s_waitcnt vmcnt(0)" ::: "memory");
        unsigned* cw = cnt + 64 * u.pm;
        if ((threadIdx.x & 63) == 0) __hip_atomic_fetch_add(cw, 1u, __ATOMIC_RELAXED, __HIP_MEMORY_SCOPE_AGENT);
        f32x4 gq[2][2];
#pragma unroll
        for (int bj = 0; bj < 2; ++bj)
#pragma unroll
            for (int n = 0; n < 2; ++n) gq[bj][n] = *(const f32x4*)(gfin + col0 + bj * 32 + n * 4);
        { unsigned spins = 0;
          while ((unsigned)__builtin_amdgcn_readfirstlane(__hip_atomic_load(cw, __ATOMIC_RELAXED, __HIP_MEMORY_SCOPE_AGENT)) < 32u) { __builtin_amdgcn_s_sleep(2); if (++spins > (1u << 22)) break; } }
        float dl_ = 0.f;
#ifdef PROBE_A
        if (blockIdx.x == 0) { const unsigned long long* T_ = (const unsigned long long*)tsb;
            const float ta = (float)(T_[PROBE_A1] - T_[PROBE_A]) * 0.01f, tb = (float)(T_[PROBE_B1] - T_[PROBE_B]) * 0.01f;
            const int qa = min(127, max(0, (int)(ta * (1.0f / PROBE_SCALE) + 0.5f))), qb = min(127, max(0, (int)(tb * (1.0f / PROBE_SCALE) + 0.5f)));
            dl_ = sqrtf((float)(qa + 128 * qb) * 9.399e-7f); }
#endif
        asm volatile("" ::: "memory");
#pragma unroll
        for (int ai = 0; ai < 2; ++ai)
#pragma unroll
            for (int m = 0; m < 4; ++m) { const int row = row0 + ai * HALF + m * 16; const size_t off = (size_t)row * ldc + col0;
                const float r = rs_from_ss(__hip_atomic_load(ssout + row, __ATOMIC_RELAXED, __HIP_MEMORY_SCOPE_AGENT), 1.0f / 1024.0f);
#pragma unroll
                for (int bj = 0; bj < 2; ++bj)
#pragma unroll
                    for (int n = 0; n < 2; ++n) *(f32x4*)(out + off + bj * 32 + n * 4) = acc[ai][bj][m][n] * r * gq[bj][n] + dl_; }
    }
};
template <class Epi, class Sched, bool ALIGN_EPI = false, bool SP2 = false>
__device__ __forceinline__ void gemm_phase(PG8_LAS unsigned char* lds, const Gemm g, const Sched& S, const Epi& E) {
    const int tid = threadIdx.x, wid = __builtin_amdgcn_readfirstlane(tid >> 6), lane = tid & 63, wr = wid >> 2, wc = wid & 3, fr = lane & 15, fq = lane >> 4;
    const int K = g.K, nt = K / BK;
    unsigned voffA[2], voffB[2];
#pragma unroll
    for (int i = 0; i < 2; ++i) { int R, C; stage_rc(tid * 16 + i * 8192, R, C); const int Rl = Epi::PERM ? perm32(R & 31) : (R & 31); const int Rb = Epi::WIDE ? (64 * (R >> 5) + Rl) : ((R & ~31) + Rl);
        voffA[i] = (unsigned)(R * K + C) * 2u; voffB[i] = (unsigned)(Rb * K + C) * 2u; }
    const size_t kstep = (size_t)(BK * 2);
    const size_t hstepB = Epi::WIDE ? (size_t)32 * K * 2 : (size_t)HALF * K * 2;
    const size_t hstep = (size_t)HALF * K * 2;
    const size_t tstep = 2 * hstep;
    const unsigned ldsw = (unsigned)wid * 1024u;
    const int aoff = lds_byte(wr * 64 + fr, fq * 8), boff = lds_byte(wc * 32 + fr, fq * 8);
#define PG8_SA(b, h) (((b) * 2 + (h)) * HTB)
#define PG8_SB(b, h) ((4 + (b) * 2 + (h)) * HTB)
#define PG8_STAGE(bufoff, gbase, voff) do { _Pragma("unroll") for (int _i = 0; _i < 2; ++_i) \
        __builtin_amdgcn_global_load_lds((const unsigned*)((const char*)(gbase) + (voff)[_i]), (PG8_LAS unsigned*)(lds + (bufoff) + ldsw + _i * 8192), 16, 0, 0); } while (0)
#define PG8_LDA(dst, b, h) do { _Pragma("unroll") for (int m = 0; m < 4; ++m) _Pragma("unroll") for (int k = 0; k < 2; ++k) dst[m][k] = *(const PG8_LAS bf16x8*)(lds + PG8_SA(b, h) + aoff + m * 2048 + k * 1024); } while (0)
#define PG8_LDB(dst, b, h) do { _Pragma("unroll") for (int n = 0; n < 2; ++n) _Pragma("unroll") for (int k = 0; k < 2; ++k) dst[n][k] = *(const PG8_LAS bf16x8*)(lds + PG8_SB(b, h) + boff + n * 2048 + k * 1024); } while (0)
#define PG8_MMA(ai, bj, At, Bt) do { __builtin_amdgcn_s_setprio(1); _Pragma("unroll") for (int m = 0; m < 4; ++m) _Pragma("unroll") for (int n = 0; n < 2; ++n) _Pragma("unroll") for (int k = 0; k < 2; ++k) \
        acc[ai][bj][m][n] = __builtin_amdgcn_mfma_f32_16x16x32_bf16(Bt[n][k], At[m][k], acc[ai][bj][m][n], 0, 0, 0); __builtin_amdgcn_s_setprio(0); } while (0)
#define PG8_WAIT_V(n) asm volatile("s_waitcnt vmcnt(" #n ")" ::: "memory")
#define PG8_WAIT_L(n) asm volatile("s_waitcnt lgkmcnt(" #n ")" ::: "memory")
#define PG8_BAR __builtin_amdgcn_s_barrier()
#define PG8_SCHED __builtin_amdgcn_sched_barrier(0)
    Unit cur, nxt; int ui = 0;
    if (!S.next(0, cur)) return;
    typename Epi::Pre rsv;
    if constexpr (Epi::RS_PREFETCH) E.load_rs(rsv, cur, wr, wc, fr, fq);
    f32x4 acc[2][2][4][2];
#pragma unroll
    for (int a = 0; a < 2; ++a)
#pragma unroll
        for (int b = 0; b < 2; ++b)
#pragma unroll
            for (int m = 0; m < 4; ++m)
#pragma unroll
                for (int n = 0; n < 2; ++n) acc[a][b][m][n] = (f32x4){0.f, 0.f, 0.f, 0.f};
    bf16x8 At[4][2], B0[2][2], B1[2][2];
    const char* cA = (const char*)g.A + (size_t)cur.pm * tstep; const char* cB = (const char*)g.Bt + (size_t)cur.pn * tstep;
    S.a_ready(cur);
    if constexpr (SP2) {
        PG8_STAGE(PG8_SB(0, 0), cB, voffB); PG8_STAGE(PG8_SB(0, 1), cB + hstepB, voffB); PG8_STAGE(PG8_SA(0, 0), cA, voffA); PG8_STAGE(PG8_SA(0, 1), cA + hstep, voffA);
        if (wr == 1) PG8_BAR;
        PG8_WAIT_V(2); PG8_BAR;
        PG8_STAGE(PG8_SB(1, 0), cB + kstep, voffB); PG8_STAGE(PG8_SA(1, 0), cA + kstep, voffA); PG8_STAGE(PG8_SB(1, 1), cB + hstepB + kstep, voffB);
        PG8_WAIT_V(6); PG8_BAR;
    } else {
        PG8_STAGE(PG8_SB(0, 0), cB, voffB); PG8_STAGE(PG8_SA(0, 0), cA, voffA); PG8_STAGE(PG8_SB(0, 1), cB + hstepB, voffB); PG8_STAGE(PG8_SA(0, 1), cA + hstep, voffA);
        if (wr == 1) PG8_BAR;
        PG8_WAIT_V(4); PG8_BAR;
        PG8_STAGE(PG8_SB(1, 0), cB + kstep, voffB); PG8_STAGE(PG8_SA(1, 0), cA + kstep, voffA); PG8_STAGE(PG8_SB(1, 1), cB + hstepB + kstep, voffB);
        PG8_WAIT_V(6); PG8_BAR;
    }
    for (;;) {
        const bool has_next = S.next(ui + 1, nxt);
        const char* nA = has_next ? (const char*)g.A + (size_t)nxt.pm * tstep : cA; const char* nB = has_next ? (const char*)g.Bt + (size_t)nxt.pn * tstep : cB;
#pragma nounroll
        for (int t = 0; t < nt; t += 2) {
            const bool last = (t == nt - 2);
            const char* a1 = cA + (size_t)(t + 1) * kstep;
            const char* a2 = last ? nA : cA + (size_t)(t + 2) * kstep; const char* b2 = last ? nB : cB + (size_t)(t + 2) * kstep;
            const char* a3 = a2 + kstep; const char* b3 = b2 + kstep;
            if (last && has_next) S.a_ready(nxt);
            if constexpr (SP2) {
            PG8_LDB(B0, 0, 0); PG8_LDB(B1, 0, 1); PG8_SCHED; PG8_LDA(At, 0, 0); PG8_STAGE(PG8_SA(1, 1), a1 + hstep, voffA);
            PG8_WAIT_V(8); PG8_WAIT_L(0); PG8_BAR; PG8_MMA(0, 0, At, B0); PG8_MMA(0, 1, At, B1); PG8_BAR; PG8_SCHED;
            PG8_LDA(At, 0, 1); PG8_STAGE(PG8_SB(0, 0), b2, voffB); PG8_STAGE(PG8_SB(0, 1), b2 + hstepB, voffB); PG8_STAGE(PG8_SA(0, 0), a2, voffA);
            PG8_WAIT_V(8); PG8_WAIT_L(0); PG8_BAR; PG8_MMA(1, 0, At, B0); PG8_MMA(1, 1, At, B1); PG8_BAR; PG8_SCHED;
            PG8_LDB(B0, 1, 0); PG8_LDB(B1, 1, 1); PG8_SCHED; PG8_LDA(At, 1, 0); PG8_STAGE(PG8_SA(0, 1), a2 + hstep, voffA);
            PG8_WAIT_V(8); PG8_WAIT_L(0); PG8_BAR; PG8_MMA(0, 0, At, B0); PG8_MMA(0, 1, At, B1); PG8_BAR; PG8_SCHED;
            PG8_LDA(At, 1, 1); PG8_STAGE(PG8_SB(1, 0), b3, voffB); PG8_STAGE(PG8_SB(1, 1), b3 + hstepB, voffB); PG8_STAGE(PG8_SA(1, 0), a3, voffA);
            PG8_WAIT_V(8); PG8_WAIT_L(0); PG8_BAR; PG8_MMA(1, 0, At, B0); PG8_MMA(1, 1, At, B1); PG8_BAR; PG8_SCHED;
            } else {
            PG8_LDB(B0, 0, 0); PG8_SCHED; PG8_LDA(At, 0, 0); PG8_STAGE(PG8_SA(1, 1), a1 + hstep, voffA);
            PG8_WAIT_L(8); PG8_BAR; PG8_WAIT_L(0); PG8_MMA(0, 0, At, B0); PG8_BAR; PG8_SCHED;
            PG8_LDB(B1, 0, 1); PG8_STAGE(PG8_SB(0, 0), b2, voffB);
            PG8_BAR; PG8_WAIT_L(0); PG8_MMA(0, 1, At, B1); PG8_BAR;
            PG8_LDA(At, 0, 1); PG8_STAGE(PG8_SA(0, 0), a2, voffA);
            PG8_BAR; PG8_WAIT_L(0); PG8_MMA(1, 0, At, B0); PG8_BAR; PG8_SCHED;
            PG8_STAGE(PG8_SB(0, 1), b2 + hstepB, voffB);
            PG8_WAIT_V(6); PG8_BAR; PG8_MMA(1, 1, At, B1); PG8_BAR;
            PG8_LDB(B0, 1, 0); PG8_SCHED; PG8_LDA(At, 1, 0); PG8_STAGE(PG8_SA(0, 1), a2 + hstep, voffA);
            PG8_WAIT_L(8); PG8_BAR; PG8_WAIT_L(0); PG8_MMA(0, 0, At, B0); PG8_BAR; PG8_SCHED;
            PG8_LDB(B1, 1, 1); PG8_STAGE(PG8_SB(1, 0), b3, voffB);
            PG8_BAR; PG8_WAIT_L(0); PG8_MMA(0, 1, At, B1); PG8_BAR;
            PG8_LDA(At, 1, 1); PG8_STAGE(PG8_SA(1, 0), a3, voffA);
            PG8_BAR; PG8_WAIT_L(0); PG8_MMA(1, 0, At, B0); PG8_BAR; PG8_SCHED;
            PG8_STAGE(PG8_SB(1, 1), b3 + hstepB, voffB);
            PG8_WAIT_V(6); PG8_BAR; PG8_MMA(1, 1, At, B1); PG8_BAR;
            }
        }
        if constexpr (ALIGN_EPI) { if (wr == 0) PG8_BAR; }
        if constexpr (!Epi::AFTER_DRAIN) { if constexpr (Epi::RS_PREFETCH) { E(acc, cur, wr, wc, fr, fq, rsv); if (has_next) E.load_rs(rsv, nxt, wr, wc, fr, fq); } else { E(acc, cur, wr, wc, fr, fq); } S.done(cur); }
        if (!has_next) break;
#pragma unroll
        for (int a = 0; a < 2; ++a)
#pragma unroll
            for (int b = 0; b < 2; ++b)
#pragma unroll
                for (int m = 0; m < 4; ++m)
#pragma unroll
                    for (int n = 0; n < 2; ++n) acc[a][b][m][n] = (f32x4){0.f, 0.f, 0.f, 0.f};
        cur = nxt; cA = nA; cB = nB; ++ui;
        if constexpr (ALIGN_EPI) { if (wr == 1) PG8_BAR; }
    }
    PG8_WAIT_V(0);
    if constexpr (!ALIGN_EPI) { if (wr == 0) PG8_BAR; }
    PG8_BAR;
    if constexpr (Epi::AFTER_DRAIN) { E.fused(acc, cur, wr, wc, fr, fq, lds, wid, lane); S.done(cur); }
#undef PG8_SA
#undef PG8_SB
#undef PG8_STAGE
#undef PG8_LDA
#undef PG8_LDB
#undef PG8_MMA
#undef PG8_WAIT_V
#undef PG8_WAIT_L
#undef PG8_BAR
#undef PG8_SCHED
}
}

#include <hip/hip_cooperative_groups.h>
namespace cg = cooperative_groups;

#ifndef MK_N_LAUNCHES
#define MK_N_LAUNCHES 1
#endif
constexpr int NWAVES = 8;
constexpr int NPHASE = 9;
constexpr int BATCH = 8, SEQ = 4096, DM = 1024, MTOK = BATCH * SEQ, DFF = 2816, PLE = 256;
constexpr size_t MiB = 1u << 20;
constexpr size_t WS_SS = 0;
constexpr size_t WS_W1IN = 1 * MiB, WS_W1OUT = 12 * MiB, WS_WMIX = 18 * MiB, WS_WMO = 23 * MiB, WS_W2IN = 25 * MiB, WS_W2OUT = 36 * MiB, WS_WG = 42 * MiB, WS_WP = 44 * MiB;
constexpr size_t WS_HB = 45 * MiB;
constexpr size_t WS_MIXED = 109 * MiB;
constexpr size_t WS_PB = 173 * MiB;
constexpr size_t WS_BIG = 189 * MiB;
constexpr size_t WS_GVT = WS_BIG + 96 * MiB;
constexpr size_t WS_END = WS_BIG + 176 * MiB;
constexpr int RING_BYTES = 131072, LDS_BYTES = 147456;
constexpr int GVT_PITCH = MTOK + 2176;

typedef unsigned short bf16;
typedef float f32x4 __attribute__((ext_vector_type(4)));
typedef float f32x16 __attribute__((ext_vector_type(16)));
typedef short bf16x8 __attribute__((ext_vector_type(8)));
typedef short s16x4 __attribute__((ext_vector_type(4)));
typedef unsigned u32x4 __attribute__((ext_vector_type(4)));
typedef unsigned u32x2 __attribute__((ext_vector_type(2)));
#define LAS __attribute__((address_space(3)))

__device__ __forceinline__ unsigned pk2(float lo, float hi) { return pg8::cvt_pk_bf16(lo, hi); }
__device__ __forceinline__ float wave_sum(float v) {
#pragma unroll
    for (int o = 1; o < 64; o <<= 1) v += __shfl_xor(v, o);
    return v;
}
__device__ __forceinline__ int crow(int r, int hi) { return (r & 3) + 8 * (r >> 2) + 4 * hi; }

__device__ __forceinline__ void p0_transpose_item(const float* W, int K, int N, bf16* WT, const float* gain, int mapkind, LAS float* scr, int item, int lane) {
    const int nblk = N / 32, kb = item / nblk, nb = item % nblk, k0 = 64 * kb, n0 = 32 * nb;
    int d0 = n0;
    if (mapkind == 1) { const bool up = n0 >= DFF; const int j = up ? n0 - DFF : n0; d0 = (j >> 7) * 256 + (up ? 128 : 0) + (j & 127); }
    else if (mapkind == 2) { d0 = n0 < 512 ? n0 : n0 < 1024 ? 1536 + (n0 - 512) : n0 < 2048 ? 512 + (n0 - 1024) : n0; }
    { f32x4 v[8]; float gq[8];
#pragma unroll
      for (int i = 0; i < 8; ++i) { const int kk = (lane >> 3) + 8 * i; v[i] = __builtin_nontemporal_load((const f32x4*)(W + (size_t)(k0 + kk) * N + n0 + 4 * (lane & 7))); gq[i] = gain ? gain[k0 + kk] : 1.0f; }
#pragma unroll
      for (int i = 0; i < 8; ++i) { const int kk = (lane >> 3) + 8 * i; LAS float* d = scr + kk * 33 + 4 * (lane & 7); d[0] = v[i][0] * gq[i]; d[1] = v[i][1] * gq[i]; d[2] = v[i][2] * gq[i]; d[3] = v[i][3] * gq[i]; } }
    asm volatile("s_waitcnt lgkmcnt(0)" ::: "memory");
    const int c = lane & 7;
#pragma unroll
    for (int j = 0; j < 4; ++j) { const int n = (lane >> 3) + 8 * j; const LAS float* s = scr + (8 * c) * 33 + n;
        u32x4 o; o.x = pk2(s[0 * 33], s[1 * 33]); o.y = pk2(s[2 * 33], s[3 * 33]); o.z = pk2(s[4 * 33], s[5 * 33]); o.w = pk2(s[6 * 33], s[7 * 33]);
        *(u32x4*)(WT + (size_t)(d0 + n) * K + k0 + 8 * c) = o; }
    asm volatile("s_waitcnt lgkmcnt(0)" ::: "memory");
}

#define XB_TMO      128
#define XB_XCNT(j)  (256  + 64 * (j))
#define XB_XSUB(j)  (1280 + 64 * (j))
#define XB_XGEN(j)  (2304 + 64 * (j))
#define XB_TOP      3328
#define XB_TOPGEN   3392
#define XCD_BAR_WORDS 3456
#define XB_SPIN_CAP (1u << 18)

__device__ __forceinline__ unsigned xb_ld(unsigned* p)              { return __hip_atomic_load(p, __ATOMIC_RELAXED, __HIP_MEMORY_SCOPE_AGENT); }
__device__ __forceinline__ unsigned xb_add(unsigned* p, unsigned v) { return __hip_atomic_fetch_add(p, v, __ATOMIC_RELAXED, __HIP_MEMORY_SCOPE_AGENT); }
__device__ __forceinline__ unsigned xb_xcc_id() { return (unsigned)__builtin_amdgcn_s_getreg((3 << 11) | 20) & 0xFu; }
#define XB_SPIN(cond, bar) do { unsigned _sp = 0; while (cond) { __builtin_amdgcn_s_sleep(1); \
    if ((++_sp & 255u) == 0u) { if (xb_ld(&(bar)[XB_TMO])) break; if (_sp > XB_SPIN_CAP) { atomicAdd(&(bar)[XB_TMO], 1u); break; } } } } while (0)

struct XcdBarrier {
    unsigned* bar; unsigned x;
    volatile LAS unsigned* st;
};

__device__ __forceinline__ XcdBarrier xcd_barrier_post(unsigned* bar, volatile LAS unsigned* st) {
    XcdBarrier b; b.bar = bar; b.x = xb_xcc_id(); b.st = st;
    if (threadIdx.x == 0) (void)xb_add(&bar[XB_XCNT(b.x)], 1u);
    return b;
}
__device__ __forceinline__ void xcd_barrier_complete(unsigned* bar, unsigned x, unsigned& nloc, unsigned& nx) {
    const unsigned G = gridDim.x * gridDim.y * gridDim.z;
    unsigned sum, cnt, mine, sp = 0u;
    for (;;) {
        sum = 0u; cnt = 0u; mine = 0u;
#pragma unroll
        for (unsigned j = 0; j < 16; ++j) { const unsigned c = xb_ld(&bar[XB_XCNT(j)]); sum += c; cnt += (c > 0u) ? 1u : 0u; mine = (j == x) ? c : mine; }
        if (sum == G) break;
        __builtin_amdgcn_s_sleep(1);
        if ((++sp & 255u) == 0u) { if (xb_ld(&bar[XB_TMO])) break; if (sp > XB_SPIN_CAP) { atomicAdd(&bar[XB_TMO], 1u); break; } }
    }
    nloc = mine > 0u ? mine : 1u; nx = cnt > 0u ? cnt : 1u;
}

__device__ __forceinline__ void xcd_barrier(const XcdBarrier& b) {
    asm volatile("s_waitcnt vmcnt(0)" ::: "memory");
    __syncthreads();
    if (threadIdx.x == 0) {
        unsigned* bar = b.bar;
        __builtin_amdgcn_s_waitcnt(0);
        unsigned nloc = b.st[0], nx = b.st[1];
        if (nloc == 0u) { xcd_barrier_complete(bar, b.x, nloc, nx); b.st[0] = nloc; b.st[1] = nx; }
        const unsigned old = xb_add(&bar[XB_XSUB(b.x)], 1u);
        const unsigned gen = old / nloc;
        if (old + 1u == (gen + 1u) * nloc) {
            __builtin_amdgcn_fence(__ATOMIC_RELEASE, "agent");
            asm volatile("s_waitcnt vmcnt(0)" ::: "memory");
            const unsigned og = xb_add(&bar[XB_TOP], 1u);
            const unsigned tg = og / nx;
            if (og + 1u == (tg + 1u) * nx) xb_add(&bar[XB_TOPGEN], 1u);
            else XB_SPIN(xb_ld(&bar[XB_TOPGEN]) == tg, bar);
            __builtin_amdgcn_fence(__ATOMIC_ACQUIRE, "agent");
            xb_add(&bar[XB_XGEN(b.x)], 1u);
            asm volatile("s_waitcnt vmcnt(0)" ::: "memory");
        } else {
            XB_SPIN(xb_ld(&bar[XB_XGEN(b.x)]) == gen, bar);
            __builtin_amdgcn_fence(__ATOMIC_ACQUIRE, "agent");
            asm volatile("s_waitcnt vmcnt(0)" ::: "memory");
        }
    }
    __syncthreads();
}

constexpr size_t WS_CTL = 768 * 1024;
#ifndef REP0
#define REP0 1
#endif
#ifndef REP1
#define REP1 1
#endif
#ifndef REP4
#define REP4 1
#endif
__device__ __forceinline__ void store_tile_rows(LAS unsigned char* wl, const float (&v0)[16], const float (&v1)[16], bf16* dst, int pitch, int lane) {
    const int r32 = lane & 31, hi = lane >> 5;
#pragma unroll
    for (int g = 0; g < 4; ++g) {
        u32x2 a; a.x = pk2(v0[4 * g], v0[4 * g + 1]); a.y = pk2(v0[4 * g + 2], v0[4 * g + 3]); *(LAS u32x2*)(wl + r32 * 144 + (8 * g + 4 * hi) * 2) = a;
        u32x2 b; b.x = pk2(v1[4 * g], v1[4 * g + 1]); b.y = pk2(v1[4 * g + 2], v1[4 * g + 3]); *(LAS u32x2*)(wl + r32 * 144 + (32 + 8 * g + 4 * hi) * 2) = b; }
    asm volatile("s_waitcnt lgkmcnt(0)" ::: "memory");
#pragma unroll
    for (int i = 0; i < 4; ++i) { const int row = (lane >> 3) + 8 * i, ch = lane & 7;
        const u32x4 w = *(const LAS u32x4*)(wl + row * 144 + ch * 16); *(u32x4*)(dst + (size_t)row * pitch + ch * 8) = w; }
    asm volatile("s_waitcnt lgkmcnt(0)" ::: "memory");
}

#ifndef FFN_WGM
#define FFN_WGM 4
#endif
#ifndef ATT_THR
#define ATT_THR -40.0f
#endif
struct Args { const float* in[18]; float* out; unsigned char* ws; int ph_lo, ph_hi; };

__device__ __forceinline__ void attn_wave_unit(const bf16* UQK, const bf16* VT, bf16* MIXED, int b, int h, int qi, int lane, LAS unsigned char* wl) {
    const int r32 = lane & 31, hi = lane >> 5;
    const size_t tokb = (size_t)b * SEQ; const int t0 = qi * 32;
    const bf16* qp = UQK + (tokb + t0 + r32) * 1536 + 512 + h * 64 + 8 * hi;
    bf16x8 qf[4];
#pragma unroll
    for (int d = 0; d < 4; ++d) qf[d] = *(const bf16x8*)(qp + 16 * d);
    f32x16 o0, o1;
#pragma unroll
    for (int i = 0; i < 16; ++i) { o0[i] = 0.f; o1[i] = 0.f; }
    float carry = 0.f;
    const bf16* kbase = UQK + (tokb + r32) * 1536 + 1024 + h * 64 + 8 * hi;
    const bf16* vbase = VT + (size_t)16 * 1024 * 1024 + (size_t)(h * 1024 + b * 128) * 2048 + lane * 8;
    bf16x8 kfA[4], kfB[4], kfC[4], kfD[4]; bf16x8 vtA[2][2], vtB[2][2], vtC[2][2], vtD[2][2];
#define ATT_LOAD(KF, VT, s0_) do { \
        _Pragma("unroll") for (int d = 0; d < 4; ++d) KF[d] = *(const bf16x8*)(kbase + (size_t)(s0_) * 1536 + 16 * d); \
        _Pragma("unroll") for (int db = 0; db < 2; ++db) _Pragma("unroll") for (int j = 0; j < 2; ++j) \
            VT[db][j] = *(const bf16x8*)(vbase + (size_t)((s0_) >> 5) * 2048 + (db * 2 + j) * 512); } while (0)
#define VFRAG(VT, db, j) (VT[db][j])
#define ATT_BLOCK(KF, VT, kb_) do { \
        f32x16 z; \
        _Pragma("unroll") for (int i = 0; i < 16; ++i) z[i] = 0.f; \
        _Pragma("unroll") for (int d = 0; d < 4; ++d) z = __builtin_amdgcn_mfma_f32_32x32x16_bf16(KF[d], qf[d], z, 0, 0, 0); \
        const bool diag = ((kb_) == qi); \
        float l[16]; \
        _Pragma("unroll") for (int i = 0; i < 16; ++i) { const float zz = z[i]; const float e = __builtin_amdgcn_exp2f(-fabsf(zz) * 1.4426950408889634f); \
            const float sp = fmaxf(zz, 0.f) + 0.6931471805599453f * __builtin_amdgcn_logf(1.0f + e); \
            const bool valid = !diag || (crow(i, hi) < r32); l[i] = valid ? -sp : 0.f; } \
        float Gs[4], Go[4], T[4]; \
        _Pragma("unroll") for (int g = 0; g < 4; ++g) { Gs[g] = (l[4 * g] + l[4 * g + 1]) + (l[4 * g + 2] + l[4 * g + 3]); Go[g] = __shfl_xor(Gs[g], 32); T[g] = Gs[g] + Go[g]; } \
        float aft[4]; aft[3] = 0.f; aft[2] = T[3]; aft[1] = T[3] + T[2]; aft[0] = aft[1] + T[1]; \
        const float total = aft[0] + T[0]; \
        float a[16]; \
        _Pragma("unroll") for (int g = 0; g < 4; ++g) { float run = aft[g] + (hi == 0 ? Go[g] : 0.f) + carry; \
            _Pragma("unroll") for (int j = 3; j >= 0; --j) { const int i = 4 * g + j; run += l[i]; const bool valid = !diag || (crow(i, hi) < r32); \
                a[i] = valid ? __builtin_amdgcn_exp2f((z[i] + run) * 1.4426950408889634f) : 0.f; } } \
        carry += total; \
        u32x4 p0, p1; \
        p0.x = pk2(a[0], a[1]); p0.y = pk2(a[2], a[3]); p0.z = pk2(a[4], a[5]); p0.w = pk2(a[6], a[7]); \
        p1.x = pk2(a[8], a[9]); p1.y = pk2(a[10], a[11]); p1.z = pk2(a[12], a[13]); p1.w = pk2(a[14], a[15]); \
        const bf16x8 pb0 = __builtin_bit_cast(bf16x8, p0), pb1 = __builtin_bit_cast(bf16x8, p1); \
        o0 = __builtin_amdgcn_mfma_f32_32x32x16_bf16(VFRAG(VT, 0, 0), pb0, o0, 0, 0, 0); \
        o0 = __builtin_amdgcn_mfma_f32_32x32x16_bf16(VFRAG(VT, 0, 1), pb1, o0, 0, 0, 0); \
        o1 = __builtin_amdgcn_mfma_f32_32x32x16_bf16(VFRAG(VT, 1, 0), pb0, o1, 0, 0, 0); \
        o1 = __builtin_amdgcn_mfma_f32_32x32x16_bf16(VFRAG(VT, 1, 1), pb1, o1, 0, 0, 0); } while (0)
    ATT_LOAD(kfA, vtA, t0); ATT_LOAD(kfB, vtB, (qi > 0 ? qi - 1 : 0) * 32); ATT_LOAD(kfC, vtC, (qi > 1 ? qi - 2 : 0) * 32); ATT_LOAD(kfD, vtD, (qi > 2 ? qi - 3 : 0) * 32);
    ATT_BLOCK(kfA, vtA, qi);
    if (qi >= 1 && !__all(carry < ATT_THR)) {
        ATT_BLOCK(kfB, vtB, qi - 1);
        if (qi >= 2 && !__all(carry < ATT_THR)) {
            ATT_BLOCK(kfC, vtC, qi - 2);
            if (qi >= 3 && !__all(carry < ATT_THR)) {
                ATT_BLOCK(kfD, vtD, qi - 3);
                for (int kb = qi - 4; kb >= 0; --kb) {
                    if (__all(carry < ATT_THR)) break;
                    ATT_LOAD(kfA, vtA, kb * 32);
                    ATT_BLOCK(kfA, vtA, kb);
                }
            }
        }
    }
#undef ATT_LOAD
#undef ATT_BLOCK
#undef VFRAG
    { float v0[16], v1[16];
#pragma unroll
      for (int i = 0; i < 16; ++i) { v0[i] = o0[i]; v1[i] = o1[i]; }
      store_tile_rows(wl, v0, v1, MIXED + (tokb + t0) * 1024 + 512 + h * 64, 1024, lane); }
}

__device__ __forceinline__ void gmlp_unit(const bf16* UQK, const bf16* GVT, bf16* MIXED, const float* w_s, const float* b_s, const float* vgain, const float* ssgv, int b, int c, int h, int wave, int lane, int flip, LAS unsigned char* wl) {
    const int r32 = lane & 31, hi = lane >> 5, tb = flip ? 3 - (wave >> 1) : (wave >> 1), dbp = wave & 1;
    const size_t tokbase = (size_t)b * SEQ + (size_t)c * 128; const int t0 = 32 * tb, t = t0 + r32;
    const float* wrow = w_s + ((size_t)h * 128 + t) * 128 + 8 * hi;
    f32x16 acc0, acc1;
#pragma unroll
    for (int i = 0; i < 16; ++i) { acc0[i] = 0.f; acc1[i] = 0.f; }
    const int nks = 2 * (tb + 1);
    const bf16* g0p = GVT + (((size_t)((b * 32 + c) * 4 + h) * 32 + 2 * dbp * 8) * 64 + lane) * 8;
    const float bb = b_s[h * 128 + t];
    const size_t tok = tokbase + t;
    u32x2 gu[2][4]; f32x4 vg[2][4];
#pragma unroll
    for (int dd = 0; dd < 2; ++dd)
#pragma unroll
        for (int g = 0; g < 4; ++g) { const int col = h * 128 + 64 * dbp + 32 * dd + 8 * g + 4 * hi; gu[dd][g] = *(const u32x2*)(UQK + tok * 1536 + col); vg[dd][g] = *(const f32x4*)(vgain + col); }
#pragma unroll
    for (int half = 0; half < 2; ++half) {
        if (4 * half < nks) {
            f32x4 w0[4], w1[4], q0[4], q1[4]; bf16x8 a0[4], a1[4];
#pragma unroll
            for (int k4 = 0; k4 < 4; ++k4) { const int ks = 4 * half + k4; const int s = 16 * ks + 8 * hi;
                if (ks < nks) { w0[k4] = *(const f32x4*)(wrow + 16 * ks); w1[k4] = *(const f32x4*)(wrow + 16 * ks + 4);
                    q0[k4] = *(const f32x4*)(ssgv + tokbase + s); q1[k4] = *(const f32x4*)(ssgv + tokbase + s + 4);
                    a0[k4] = *(const bf16x8*)(g0p + ks * 512); a1[k4] = *(const bf16x8*)(g0p + 8 * 512 + ks * 512); } }
#pragma unroll
            for (int k4 = 0; k4 < 4; ++k4) { const int ks = 4 * half + k4; const int s = 16 * ks + 8 * hi;
                if (ks < nks) { float v[8];
#pragma unroll
                    for (int e = 0; e < 4; ++e) { v[e] = (s + e <= t) ? w0[k4][e] * pg8::rs_from_ss(q0[k4][e], 1.0f / 512.0f) : 0.f; v[4 + e] = (s + 4 + e <= t) ? w1[k4][e] * pg8::rs_from_ss(q1[k4][e], 1.0f / 512.0f) : 0.f; }
                    u32x4 bw; bw.x = pk2(v[0], v[1]); bw.y = pk2(v[2], v[3]); bw.z = pk2(v[4], v[5]); bw.w = pk2(v[6], v[7]);
                    const bf16x8 bfrag = __builtin_bit_cast(bf16x8, bw);
                    acc0 = __builtin_amdgcn_mfma_f32_32x32x16_bf16(a0[k4], bfrag, acc0, 0, 0, 0);
                    acc1 = __builtin_amdgcn_mfma_f32_32x32x16_bf16(a1[k4], bfrag, acc1, 0, 0, 0); } }
        }
    }
    { float v0[16], v1[16];
#pragma unroll
      for (int g = 0; g < 4; ++g) { const u32x2 ga = gu[0][g], gb = gu[1][g]; const f32x4 va = vg[0][g], vb = vg[1][g];
          v0[4 * g] = pg8::bf_lo(ga.x) * (va[0] * acc0[4 * g] + bb); v0[4 * g + 1] = pg8::bf_hi(ga.x) * (va[1] * acc0[4 * g + 1] + bb); v0[4 * g + 2] = pg8::bf_lo(ga.y) * (va[2] * acc0[4 * g + 2] + bb); v0[4 * g + 3] = pg8::bf_hi(ga.y) * (va[3] * acc0[4 * g + 3] + bb);
          v1[4 * g] = pg8::bf_lo(gb.x) * (vb[0] * acc1[4 * g] + bb); v1[4 * g + 1] = pg8::bf_hi(gb.x) * (vb[1] * acc1[4 * g + 1] + bb); v1[4 * g + 2] = pg8::bf_lo(gb.y) * (vb[2] * acc1[4 * g + 2] + bb); v1[4 * g + 3] = pg8::bf_hi(gb.y) * (vb[3] * acc1[4 * g + 3] + bb); }
      store_tile_rows(wl, v0, v1, MIXED + (tokbase + t0) * 1024 + h * 128 + 64 * dbp, 1024, lane); }
}

__global__ void __launch_bounds__(NWAVES * 64, 2) mk_fwd(Args args) {
    extern __shared__ __attribute__((aligned(16))) unsigned char lds_raw[];
    LAS unsigned char* lds = (LAS unsigned char*)lds_raw;
    const int tid = threadIdx.x, lane = tid & 63, wave = __builtin_amdgcn_readfirstlane(tid >> 6);
    const int G = gridDim.x, bx = blockIdx.x;
    const int gw = bx * NWAVES + wave, NGW = G * NWAVES;
#define ws (args.ws)
#define xin (args.in[0])
#define pin (args.in[1])
#define ssx ((float*)(ws + WS_SS))
#define ss1 (ssx + MTOK)
#define ssgv (ssx + 2 * MTOK)
#define ss2 (ssx + 3 * MTOK)
#define ss3 (ssx + 4 * MTOK)
#define ss4 (ssx + 5 * MTOK)
#define W1in ((bf16*)(ws + WS_W1IN))
#define W1out ((bf16*)(ws + WS_W1OUT))
#define Wmix ((bf16*)(ws + WS_WMIX))
#define Wmo ((bf16*)(ws + WS_WMO))
#define W2in ((bf16*)(ws + WS_W2IN))
#define W2out ((bf16*)(ws + WS_W2OUT))
#define Wg ((bf16*)(ws + WS_WG))
#define Wp ((bf16*)(ws + WS_WP))
#define HB ((bf16*)(ws + WS_HB))
#define MIXED ((bf16*)(ws + WS_MIXED))
#define PB ((bf16*)(ws + WS_PB))
#define HID ((bf16*)(ws + WS_BIG))
#define UQK ((bf16*)(ws + WS_BIG))
#define GVT ((bf16*)(ws + WS_GVT))
#define SLAB ((u32x4*)(ws + WS_BIG))
#define out (args.out)
    const int lo = args.ph_lo, hi_ph = args.ph_hi;
#ifndef PHASE_MASK
#define PHASE_MASK 0x3ff
#endif
#define IN(k) (((PHASE_MASK >> (k)) & 1) && lo <= (k) && (k) < hi_ph)
#ifdef PROBE_A
#ifndef TS_BLOCK
#define TS_BLOCK 0
#endif
#define TSTAMP(k) do { if (bx == TS_BLOCK && tid == 0) ((unsigned long long*)(ws + WS_CTL + 49152))[k] = __builtin_amdgcn_s_memrealtime(); } while (0)
#else
#define TSTAMP(k) do {} while (0)
#endif
#define SEAM(k) do { if (IN(k) && IN((k) + 1)) { xcd_barrier(bar); } TSTAMP((k) + 1); } while (0)
    if (tid < 2) ((LAS unsigned*)(lds + RING_BYTES))[tid] = 0u;
    __syncthreads();
    if (args.ph_lo < 0) cg::this_grid().sync();
    TSTAMP(0);
    XcdBarrier bar = xcd_barrier_post((unsigned*)(ws + WS_CTL), (volatile LAS unsigned*)(lds + RING_BYTES));

    if (IN(0)) for (int rep = 0; rep < REP0; ++rep) {
        LAS float* scr = (LAS float*)(lds + wave * 16384);
        constexpr int I_IN = (DM / 64) * (2 * DFF / 32), I_OUT = (DFF / 64) * (DM / 32), I_MIX = (DM / 64) * (2560 / 32), I_SQ = (DM / 64) * (DM / 32), I_P = (PLE / 64) * (DM / 32);
        constexpr int NITEMS = 2 * I_IN + 2 * I_OUT + I_MIX + 2 * I_SQ + I_P;
        for (int it = gw; it < NITEMS; it += NGW) {
            int r = it;
            if (r < I_IN) { p0_transpose_item(args.in[3], DM, 2 * DFF, W1in, args.in[2], 1, scr, r, lane); continue; } r -= I_IN;
            if (r < I_IN) { p0_transpose_item(args.in[12], DM, 2 * DFF, W2in, args.in[11], 1, scr, r, lane); continue; } r -= I_IN;
            if (r < I_OUT) { p0_transpose_item(args.in[4], DFF, DM, W1out, nullptr, 0, scr, r, lane); continue; } r -= I_OUT;
            if (r < I_OUT) { p0_transpose_item(args.in[13], DFF, DM, W2out, nullptr, 0, scr, r, lane); continue; } r -= I_OUT;
            if (r < I_MIX) { p0_transpose_item(args.in[6], DM, 2560, Wmix, args.in[5], 2, scr, r, lane); continue; } r -= I_MIX;
            if (r < I_SQ) { p0_transpose_item(args.in[10], DM, DM, Wmo, nullptr, 0, scr, r, lane); continue; } r -= I_SQ;
            if (r < I_SQ) { p0_transpose_item(args.in[15], DM, DM, Wg, args.in[14], 0, scr, r, lane); continue; } r -= I_SQ;
            p0_transpose_item(args.in[16], PLE, DM, Wp, nullptr, 0, scr, r, lane);
        }
        for (int m0 = gw * 4; m0 + 3 < MTOK; m0 += NGW * 4) {
            f32x4 v[4][4];
#pragma unroll
            for (int q = 0; q < 4; ++q) { const f32x4* xr = (const f32x4*)(xin + (size_t)(m0 + q) * DM) + lane;
#pragma unroll
                for (int j = 0; j < 4; ++j) v[q][j] = __builtin_nontemporal_load(xr + 64 * j); }
#pragma unroll
            for (int q = 0; q < 4; ++q) { float s = 0.f;
#pragma unroll
                for (int j = 0; j < 4; ++j) s += (v[q][j][0] * v[q][j][0] + v[q][j][1] * v[q][j][1]) + (v[q][j][2] * v[q][j][2] + v[q][j][3] * v[q][j][3]);
                s = wave_sum(s); if (lane == 0) ssx[m0 + q] = s;
                u32x2* o8 = (u32x2*)(HB + (size_t)(m0 + q) * DM) + lane;
#pragma unroll
                for (int j = 0; j < 4; ++j) { u32x2 w; w.x = pk2(v[q][j][0], v[q][j][1]); w.y = pk2(v[q][j][2], v[q][j][3]); o8[64 * j] = w; } }
        }
        for (size_t i0 = (size_t)gw * 256 + lane; i0 < (size_t)MTOK * PLE / 8; i0 += (size_t)NGW * 256) {
            f32x4 a[4], b[4];
#pragma unroll
            for (int q = 0; q < 4; ++q) if (i0 + 64 * q < (size_t)MTOK * PLE / 8) { a[q] = __builtin_nontemporal_load((const f32x4*)pin + 2 * (i0 + 64 * q)); b[q] = __builtin_nontemporal_load((const f32x4*)pin + 2 * (i0 + 64 * q) + 1); }
#pragma unroll
            for (int q = 0; q < 4; ++q) if (i0 + 64 * q < (size_t)MTOK * PLE / 8) { u32x4 w; w.x = pk2(a[q][0], a[q][1]); w.y = pk2(a[q][2], a[q][3]); w.z = pk2(b[q][0], b[q][1]); w.w = pk2(b[q][2], b[q][3]); ((u32x4*)PB)[i0 + 64 * q] = w; }
        }
        for (int i = gw * 64 + lane; i < 5 * MTOK; i += NGW * 64) ss1[i] = 0.f;
    }
    SEAM(0);
    if (IN(1)) for (int rep = 0; rep < REP1; ++rep) {
        pg8::Gemm g{HB, W1in, MTOK, 2 * DFF, DM}; pg8::StaticOrder S; S.init(MTOK, 2 * DFF, G, bx, FFN_WGM);
        pg8::EpiSwiGLU E{HID, DFF, ssx};
        pg8::gemm_phase<pg8::EpiSwiGLU, pg8::StaticOrder, true, true>(lds, g, S, E);
    }
    SEAM(1);
    if (IN(2)) {
        pg8::Gemm g{HID, W1out, MTOK, DM, DFF}; pg8::StaticOrder S; S.init(MTOK, DM, G, bx);
        pg8::EpiResidB E{HB, ss1, 0.5f, DM, (void*)(ws + WS_CTL + 49152)};
        pg8::gemm_phase<pg8::EpiResidB, pg8::StaticOrder, true, true>(lds, g, S, E);
    }
    SEAM(2);
    if (IN(3)) {
        { pg8::Gemm g{HB, Wmix, MTOK, 1536, DM}; pg8::StaticOrder S; S.init(MTOK, 1536, G, bx);
          pg8::EpiMixTok E{UQK, 1536, ss1};
          pg8::gemm_phase<pg8::EpiMixTok, pg8::StaticOrder, true, true>(lds, g, S, E); }
        { pg8::Gemm g{Wmix + (size_t)1536 * DM, HB, 1024, MTOK, DM}; pg8::StaticOrder S; S.init(1024, MTOK, G, bx);
          pg8::EpiMixT E{GVT, GVT + (size_t)16 * 1024 * 1024, ss1, ssgv};
          pg8::gemm_phase<pg8::EpiMixT, pg8::StaticOrder, true, true>(lds, g, S, E); }
    }
    SEAM(3);
    if (IN(4)) for (int rep = 0; rep < REP4; ++rep) {
        { unsigned* qh = (unsigned*)(ws + WS_CTL + 49152 + 2048) + 128 * (bx & 7);
          const int qb = bx & 7;
          unsigned* qa = qh + 64;
#pragma nounroll
          for (int pass = 0; pass < 2; ++pass) {
            const bool doG = (pass == 0) == (wave < 4);
            if (doG) {
              unsigned nxt = 0u; if (lane == 0) nxt = atomicAdd(qh, 1u); nxt = (unsigned)__builtin_amdgcn_readfirstlane((int)nxt);
              while (nxt < 1024u) { const unsigned k = nxt; unsigned pend = 0u; if (lane == 0) pend = atomicAdd(qh, 1u);
                  const int part = 7 - (int)(k & 7u), uu = (int)(k >> 3), h = uu & 3, c = uu >> 2;
                  gmlp_unit(UQK, GVT, MIXED, args.in[8], args.in[9], args.in[7], ssgv, qb, c, h, part, lane, 0, lds + wave * 16384);
                  nxt = (unsigned)__builtin_amdgcn_readfirstlane((int)pend); }
            } else {
              unsigned nxt = 0u; if (lane == 0) nxt = atomicAdd(qa, 1u); nxt = (unsigned)__builtin_amdgcn_readfirstlane((int)nxt);
              while (nxt < 1024u) { const unsigned k = nxt; unsigned pend = 0u; if (lane == 0) pend = atomicAdd(qa, 1u);
                  const int qi = 127 - (int)(k & 127u), h = (int)(k >> 7);
                  attn_wave_unit(UQK, GVT, MIXED, qb, h, qi, lane, lds + wave * 16384);
                  nxt = (unsigned)__builtin_amdgcn_readfirstlane((int)pend); }
            }
          } }
    }
    TSTAMP(21);
#ifdef PROBE_A
#endif
    SEAM(4);
    if (IN(5)) {
        pg8::Gemm g{MIXED, Wmo, MTOK, DM, DM}; pg8::StaticOrder S; S.init(MTOK, DM, G, bx);
        pg8::EpiResidB E{HB, ss2, 1.0f, DM, (void*)(ws + WS_CTL + 49152)};
        pg8::gemm_phase<pg8::EpiResidB, pg8::StaticOrder, true, true>(lds, g, S, E);
    }
    SEAM(5);
    if (IN(6)) {
        pg8::Gemm g{HB, W2in, MTOK, 2 * DFF, DM}; pg8::StaticOrder S; S.init(MTOK, 2 * DFF, G, bx, FFN_WGM);
        pg8::EpiSwiGLU E{HID, DFF, ss2};
        pg8::gemm_phase<pg8::EpiSwiGLU, pg8::StaticOrder, true, true>(lds, g, S, E);
    }
    SEAM(6);
    if (IN(7)) {
        pg8::Gemm g{HID, W2out, MTOK, DM, DFF}; pg8::StaticOrder S; S.init(MTOK, DM, G, bx);
        pg8::EpiResidB E{HB, ss3, 0.5f, DM, (void*)(ws + WS_CTL + 49152)};
        pg8::gemm_phase<pg8::EpiResidB, pg8::StaticOrder, true, true>(lds, g, S, E);
    }
    SEAM(7);
    if (IN(8)) {
#ifndef P8_NO_PP
        { pg8::Gemm g{PB, Wp, MTOK, DM, PLE}; pg8::StaticOrder S; S.init(MTOK, DM, G, bx);
          pg8::EpiPP E{SLAB};
          pg8::gemm_phase<pg8::EpiPP, pg8::StaticOrder, true, true>(lds, g, S, E); }
#endif
        asm volatile("s_waitcnt vmcnt(0)" ::: "memory");
#ifndef P8_NO_GATE
        { pg8::Gemm g{HB, Wg, MTOK, DM, DM}; pg8::StaticOrder S; S.init(MTOK, DM, G, bx);
          pg8::EpiGate E{HB, out, SLAB, ss3, ss4, (unsigned*)(ws + WS_CTL + 16384), args.in[17], DM, (void*)(ws + WS_CTL + 49152)};
          pg8::gemm_phase<pg8::EpiGate, pg8::StaticOrder, true, true>(lds, g, S, E); }
#endif
    }
#undef IN
#undef SEAM
#undef ws
#undef xin
#undef pin
#undef ssx
#undef ss1
#undef ssgv
#undef ss2
#undef ss3
#undef ss4
#undef W1in
#undef W1out
#undef Wmix
#undef Wmo
#undef W2in
#undef W2out
#undef Wg
#undef Wp
#undef HB
#undef MIXED
#undef PB
#undef HID
#undef UQK
#undef GVT
#undef SLAB
#undef out
}

extern "C" void kernel_launch(void* const* d_in, const int* in_sizes, int n_in, void* d_out, int out_size, void* d_ws, size_t ws_size, hipStream_t stream) {
    static int grid = 0;
    if (grid == 0) {
        if (n_in != 18 || out_size != MTOK * DM || ws_size < WS_END) { fprintf(stderr, "kernel_launch: unexpected shapes (n_in %d out %d ws %zu)\n", n_in, out_size, ws_size); grid = -1; return; }
        int dev = 0, cus = 0, per_cu = 0;
        hipGetDevice(&dev); hipDeviceGetAttribute(&cus, hipDeviceAttributeMultiprocessorCount, dev);
        hipFuncSetAttribute((const void*)mk_fwd, hipFuncAttributeMaxDynamicSharedMemorySize, LDS_BYTES);
        hipOccupancyMaxActiveBlocksPerMultiprocessor(&per_cu, (const void*)mk_fwd, NWAVES * 64, LDS_BYTES);
        if (per_cu < 1) { fprintf(stderr, "kernel_launch: occupancy query says %d blocks per CU\n", per_cu); per_cu = 1; }
        (void)hipGetLastError();
        grid = cus * per_cu;
        if (grid > 256) grid = 256;
    }
    if (grid < 0) return;
    Args a{};
    for (int i = 0; i < 18; ++i) a.in[i] = (const float*)d_in[i];
    a.out = (float*)d_out; a.ws = (unsigned char*)d_ws;
    (void)hipMemsetAsync((char*)d_ws + WS_CTL, 0, 16384 + 128 * 256 + 8192, stream);
#if MK_N_LAUNCHES == 1
    a.ph_lo = 0; a.ph_hi = NPHASE;
    void* kargs[] = {&a};
    hipError_t e = hipLaunchCooperativeKernel((const void*)mk_fwd, dim3(grid), dim3(NWAVES * 64), kargs, LDS_BYTES, stream);
    if (e != hipSuccess) fprintf(stderr, "cooperative launch failed: %s (grid %d)\n", hipGetErrorString(e), grid);
#else
    for (int ph = 0; ph < NPHASE; ++ph) { a.ph_lo = ph; a.ph_hi = ph + 1; hipLaunchKernelGGL(mk_fwd, dim3(grid), dim3(NWAVES * 64), LDS_BYTES, stream, a); }
#endif
}
```

```cpp
#include <hip/hip_runtime.h>
#include <cstdio>
#include <cstdint>
#define MK_N_LAUNCHES 1
namespace pg8 {
#define PG8_LAS __attribute__((address_space(3)))
typedef unsigned short bf16_t;
typedef short bf16x8 __attribute__((ext_vector_type(8)));
typedef float f32x4 __attribute__((ext_vector_type(4)));
typedef unsigned u32x4 __attribute__((ext_vector_type(4)));
constexpr int BM = 256, BK = 64, HALF = 128, HTB = HALF * BK * 2  , STAGE_BYTES = 8 * HTB, NXCD = 8, WGM = 8;

__host__ __device__ __forceinline__ int lds_byte(int r, int c) { const int st = (r >> 4) * 2 + (c >> 5), rr = r & 15, cc = c & 31, ob = rr * 64 + cc * 2; return st * 1024 + (ob ^ (((ob >> 9) & 1) << 5)); }
__host__ __device__ __forceinline__ void stage_rc(int b, int& R, int& C) { const int st = b / 1024, sb = b % 1024, swz = sb ^ (((sb >> 9) & 1) << 5); R = (st >> 1) * 16 + swz / 64; C = (st & 1) * 32 + (swz % 64) / 2; }
__host__ __device__ __forceinline__ int perm32(int rho) { const int n = rho >> 4, i = rho & 15; return 8 * (i >> 2) + 4 * n + (i & 3); }

struct Unit { int pm, pn; };
struct Gemm { const bf16_t* A; const bf16_t* Bt; int M, N, K; };

struct StaticOrder {
    int nM, nN, nwg, G, c, wgm;
    __host__ __device__ void init(int M, int N, int G_, int c_, int wgm_ = WGM) { nM = M / BM; nN = N / BM; nwg = nM * nN; G = G_; c = c_; wgm = wgm_; }
    __host__ __device__ bool next(int i, Unit& u) const {
        const long L = (long)i * G + c; if (L >= nwg) return false;
        int wgid = (int)L; { const int q = nwg / NXCD, r = nwg % NXCD, xcd = wgid % NXCD, off = wgid / NXCD; wgid = (xcd < r ? xcd * (q + 1) : r * (q + 1) + (xcd - r) * q) + off; }
        const int nig = wgm * nN, gid = wgid / nig, fm = gid * wgm, gsz = (nM - fm) < wgm ? (nM - fm) : wgm;
        u.pm = fm + ((wgid % nig) % gsz); u.pn = (wgid % nig) / gsz; return true;
    }
    __device__ __forceinline__ void a_ready(const Unit&) const {}
    __device__ __forceinline__ void done(const Unit&) const {}
};

__device__ __forceinline__ unsigned cvt_pk_bf16(float lo, float hi) { unsigned r; asm volatile("v_cvt_pk_bf16_f32 %0, %1, %2" : "=v"(r) : "v"(lo), "v"(hi)); return r; }
typedef float f32x2 __attribute__((ext_vector_type(2)));
__device__ __forceinline__ f32x2 gelu_pk(f32x2 v) {
    const f32x2 av = __builtin_elementwise_abs(v), d = av * 0.2316418882f + 1.0f;
    f32x2 t; t.x = __builtin_amdgcn_rcpf(d.x); t.y = __builtin_amdgcn_rcpf(d.y);
    f32x2 q = t * 0.5307027145f + (-0.7265760135f); q = q * t + 0.7107068705f; q = q * t + (-0.142248368f); q = q * t + 0.127414796f; q = q * t;
    const f32x2 s = (v * v) * (-0.72134752044f);
    f32x2 e; e.x = __builtin_amdgcn_exp2f(s.x); e.y = __builtin_amdgcn_exp2f(s.y);
    const f32x2 m = v * (q * e), r = v - m;
    f32x2 o; o.x = v.x < 0.f ? m.x : r.x; o.y = v.y < 0.f ? m.y : r.y; return o;
}


constexpr float RMS_EPS = 1e-6f;
__device__ __forceinline__ float rs_from_ss(float ss, float inv_n) { return __builtin_amdgcn_rsqf(ss * inv_n + RMS_EPS); }
__device__ __forceinline__ float silu_f(float g) { return g * __builtin_amdgcn_rcpf(1.0f + __builtin_amdgcn_exp2f(g * -1.4426950408889634f)); }
__device__ __forceinline__ float sigmoid_f(float g) { return __builtin_amdgcn_rcpf(1.0f + __builtin_amdgcn_exp2f(g * -1.4426950408889634f)); }
typedef unsigned u32x2 __attribute__((ext_vector_type(2)));

struct PreF8 { float v[8]; };
struct PreNone { int dummy; };
struct EpiSwiGLU {
    typedef PreF8 Pre;
    static constexpr bool PERM = true, AFTER_DRAIN = false, RS_PREFETCH = true, WIDE = false;
    bf16_t* O; int ldc; const float* ss;
    __device__ __forceinline__ void load_rs(PreF8& rs, const Unit& u, int wr, int wc, int fr, int fq) const {
#pragma unroll
        for (int j = 0; j < 8; ++j) rs.v[j] = ss[u.pm * BM + wr * 64 + fr + (j >> 2) * HALF + (j & 3) * 16];
    }
    __device__ __forceinline__ void operator()(const f32x4 (&acc)[2][2][4][2], const Unit& u, int wr, int wc, int fr, int fq, const PreF8& rs) const {
        const int row0 = u.pm * BM + wr * 64 + fr; const int col0 = u.pn * HALF + wc * 32 + 8 * fq;
#pragma unroll
        for (int ai = 0; ai < 2; ++ai)
#pragma unroll
            for (int m = 0; m < 4; ++m) { const int row = row0 + ai * HALF + m * 16; const float r = rs_from_ss(rs.v[ai * 4 + m], 1.0f / 1024.0f);
                const float c1 = r * -1.4426950408889634f, r2 = r * r;
                const f32x4 g0 = acc[ai][0][m][0], g1 = acc[ai][0][m][1], u0 = acc[ai][1][m][0], u1 = acc[ai][1][m][1];
                f32x4 t0 = g0 * u0, t1 = g1 * u1, e0 = g0 * c1, e1 = g1 * c1, s0, s1;
#pragma unroll
                for (int i = 0; i < 4; ++i) { s0[i] = __builtin_amdgcn_rcpf(1.0f + __builtin_amdgcn_exp2f(e0[i])); s1[i] = __builtin_amdgcn_rcpf(1.0f + __builtin_amdgcn_exp2f(e1[i])); }
                t0 = t0 * (s0 * r2); t1 = t1 * (s1 * r2);
                u32x4 w; w.x = cvt_pk_bf16(t0[0], t0[1]); w.y = cvt_pk_bf16(t0[2], t0[3]); w.z = cvt_pk_bf16(t1[0], t1[1]); w.w = cvt_pk_bf16(t1[2], t1[3]);
                __builtin_nontemporal_store(w, (u32x4*)(O + (size_t)row * ldc + col0)); }
    }
};

struct EpiResidX {
    typedef PreNone Pre;
    static constexpr bool PERM = true, AFTER_DRAIN = false, RS_PREFETCH = false, WIDE = false;
    const float* res; bf16_t* ob; float* ssout; float alpha; int ldc;
    __device__ __forceinline__ void operator()(const f32x4 (&acc)[2][2][4][2], const Unit& u, int wr, int wc, int fr, int fq) const {
        const int row0 = u.pm * BM + wr * 64 + fr, col0 = u.pn * BM + wc * 32 + 8 * fq;
#pragma unroll
        for (int ai = 0; ai < 2; ++ai) {
            f32x4 rv[4][2][2];
#pragma unroll
            for (int m = 0; m < 4; ++m)
#pragma unroll
                for (int bj = 0; bj < 2; ++bj)
#pragma unroll
                    for (int n = 0; n < 2; ++n) rv[m][bj][n] = *(const f32x4*)(res + (size_t)(row0 + ai * HALF + m * 16) * ldc + col0 + bj * HALF + n * 4);
#pragma unroll
            for (int m = 0; m < 4; ++m) { const int row = row0 + ai * HALF + m * 16; const size_t off = (size_t)row * ldc + col0; float sq = 0.f;
#pragma unroll
                for (int bj = 0; bj < 2; ++bj) { const f32x4 o0 = rv[m][bj][0] + acc[ai][bj][m][0] * alpha, o1 = rv[m][bj][1] + acc[ai][bj][m][1] * alpha;
                    sq += ((o0[0] * o0[0] + o0[1] * o0[1]) + (o0[2] * o0[2] + o0[3] * o0[3])) + ((o1[0] * o1[0] + o1[1] * o1[1]) + (o1[2] * o1[2] + o1[3] * o1[3]));
                    u32x4 w; w.x = cvt_pk_bf16(o0[0], o0[1]); w.y = cvt_pk_bf16(o0[2], o0[3]); w.z = cvt_pk_bf16(o1[0], o1[1]); w.w = cvt_pk_bf16(o1[2], o1[3]); *(u32x4*)(ob + off + bj * HALF) = w; }
                sq += __shfl_xor(sq, 16); sq += __shfl_xor(sq, 32);
                if (fq == 0) atomicAdd(ssout + row, sq); }
            asm volatile("" ::: "memory"); }
    }
};
__device__ __forceinline__ float bf_lo(unsigned w) { return __uint_as_float(w << 16); }
__device__ __forceinline__ float bf_hi(unsigned w) { return __uint_as_float(w & 0xffff0000u); }
#ifdef PROBE_A
#define EPI_STAMP(T) do { if (blockIdx.x == 0 && threadIdx.x == 0) { unsigned long long* T_ = (unsigned long long*)(T); const unsigned k_ = (unsigned)T_[63]; T_[32 + k_] = __builtin_amdgcn_s_memrealtime(); T_[63] = k_ + 1; } } while (0)
#else
#define EPI_STAMP(T) do {} while (0)
#endif
struct PreRes { u32x4 v[6]; };
struct EpiResidB {
    typedef PreRes Pre;
    static constexpr bool PERM = true, AFTER_DRAIN = false, RS_PREFETCH = true, WIDE = true;
    static constexpr int NPRE = 6;
    bf16_t* hb; float* ssout; float alpha; int ldc; void* tsb;
    __device__ __forceinline__ void load_rs(PreRes& pre, const Unit& u, int wr, int wc, int fr, int fq) const {
        const int row0 = u.pm * BM + wr * 64 + fr, col0 = u.pn * BM + wc * 64 + 8 * fq;
#pragma unroll
        for (int j = 0; j < NPRE; ++j) { const int ai = j >> 3, m = (j >> 1) & 3, bj = j & 1; pre.v[j] = *(const u32x4*)(hb + (size_t)(row0 + ai * HALF + m * 16) * ldc + col0 + bj * 32); }
    }
    __device__ __forceinline__ void operator()(const f32x4 (&acc)[2][2][4][2], const Unit& u, int wr, int wc, int fr, int fq, const PreRes& pre) const {
        EPI_STAMP(tsb);
        const int row0 = u.pm * BM + wr * 64 + fr, col0 = u.pn * BM + wc * 64 + 8 * fq;
        u32x4 rv[2][4][2];
#pragma unroll
        for (int ai = 0; ai < 2; ++ai)
#pragma unroll
            for (int m = 0; m < 4; ++m)
#pragma unroll
                for (int bj = 0; bj < 2; ++bj) { const int j = ai * 8 + m * 2 + bj;
                    if (j < NPRE) rv[ai][m][bj] = pre.v[j < NPRE ? j : 0]; else rv[ai][m][bj] = *(const u32x4*)(hb + (size_t)(row0 + ai * HALF + m * 16) * ldc + col0 + bj * 32); }
#pragma unroll
        for (int ai = 0; ai < 2; ++ai)
#pragma unroll
            for (int m = 0; m < 4; ++m) { const int row = row0 + ai * HALF + m * 16; const size_t off = (size_t)row * ldc + col0; float sq = 0.f;
#pragma unroll
                for (int bj = 0; bj < 2; ++bj) { const u32x4 rw = rv[ai][m][bj];
                    const f32x4 o0 = (f32x4){bf_lo(rw.x), bf_hi(rw.x), bf_lo(rw.y), bf_hi(rw.y)} + acc[ai][bj][m][0] * alpha, o1 = (f32x4){bf_lo(rw.z), bf_hi(rw.z), bf_lo(rw.w), bf_hi(rw.w)} + acc[ai][bj][m][1] * alpha;
                    sq += ((o0[0] * o0[0] + o0[1] * o0[1]) + (o0[2] * o0[2] + o0[3] * o0[3])) + ((o1[0] * o1[0] + o1[1] * o1[1]) + (o1[2] * o1[2] + o1[3] * o1[3]));
                    u32x4 w; w.x = cvt_pk_bf16(o0[0], o0[1]); w.y = cvt_pk_bf16(o0[2], o0[3]); w.z = cvt_pk_bf16(o1[0], o1[1]); w.w = cvt_pk_bf16(o1[2], o1[3]); *(u32x4*)(hb + off + bj * 32) = w; }
                sq += __shfl_xor(sq, 16); sq += __shfl_xor(sq, 32);
                if (fq == 0) atomicAdd(ssout + row, sq); }
        EPI_STAMP(tsb);
    }
};

struct EpiMixTok {
    typedef PreF8 Pre;
    static constexpr bool PERM = true, AFTER_DRAIN = false, RS_PREFETCH = true, WIDE = true;
    bf16_t* O; int ldc; const float* ss;
    __device__ __forceinline__ void load_rs(PreF8& rs, const Unit& u, int wr, int wc, int fr, int fq) const {
#pragma unroll
        for (int j = 0; j < 8; ++j) rs.v[j] = ss[u.pm * BM + wr * 64 + fr + (j >> 2) * HALF + (j & 3) * 16];
    }
    __device__ __forceinline__ void operator()(const f32x4 (&acc)[2][2][4][2], const Unit& u, int wr, int wc, int fr, int fq, const PreF8& rs) const {
        const int row0 = u.pm * BM + wr * 64 + fr; const int col0 = u.pn * BM + wc * 64 + 8 * fq;
        const bool isu = u.pn < 2; const float sc = (u.pn == 2 || u.pn == 3) ? 0.125f : 1.0f;
#pragma unroll
        for (int ai = 0; ai < 2; ++ai)
#pragma unroll
            for (int m = 0; m < 4; ++m) { const int row = row0 + ai * HALF + m * 16; const float r = rs_from_ss(rs.v[ai * 4 + m], 1.0f / 1024.0f) * sc;
#pragma unroll
                for (int bj = 0; bj < 2; ++bj) { f32x4 v0 = acc[ai][bj][m][0] * r, v1 = acc[ai][bj][m][1] * r;
                    if (isu) { const f32x2 a = gelu_pk((f32x2){v0[0], v0[1]}), b = gelu_pk((f32x2){v0[2], v0[3]}), c = gelu_pk((f32x2){v1[0], v1[1]}), d = gelu_pk((f32x2){v1[2], v1[3]});
                        v0 = (f32x4){a.x, a.y, b.x, b.y}; v1 = (f32x4){c.x, c.y, d.x, d.y}; }
                    u32x4 w; w.x = cvt_pk_bf16(v0[0], v0[1]); w.y = cvt_pk_bf16(v0[2], v0[3]); w.z = cvt_pk_bf16(v1[0], v1[1]); w.w = cvt_pk_bf16(v1[2], v1[3]);
                    *(u32x4*)(O + (size_t)row * ldc + col0 + bj * 32) = w; } }
    }
};

struct EpiMixT {
    typedef PreNone Pre;
    static constexpr bool PERM = true, AFTER_DRAIN = false, RS_PREFETCH = false, WIDE = true;
    bf16_t* GT; bf16_t* VT; const float* ss; float* ssgv;
    __device__ __forceinline__ void operator()(const f32x4 (&acc)[2][2][4][2], const Unit& u, int wr, int wc, int fr, int fq) const {
        const int row0 = u.pm * BM + wr * 64 + fr; const int col0 = u.pn * BM + wc * 64 + 8 * fq;
        const bool isg = u.pm < 2;
        f32x4 rt[2][2], cs[2][2];
#pragma unroll
        for (int bj = 0; bj < 2; ++bj)
#pragma unroll
            for (int n = 0; n < 2; ++n) { const f32x4 s = *(const f32x4*)(ss + col0 + bj * 32 + 4 * n);
                rt[bj][n] = (f32x4){rs_from_ss(s[0], 1.0f / 1024.0f), rs_from_ss(s[1], 1.0f / 1024.0f), rs_from_ss(s[2], 1.0f / 1024.0f), rs_from_ss(s[3], 1.0f / 1024.0f)};
                cs[bj][n] = (f32x4){0.f, 0.f, 0.f, 0.f}; }
#pragma unroll
        for (int ai = 0; ai < 2; ++ai)
#pragma unroll
            for (int m = 0; m < 4; ++m) { const int c = row0 + ai * HALF + m * 16;
#pragma unroll
                for (int bj = 0; bj < 2; ++bj) { f32x4 v0 = acc[ai][bj][m][0] * rt[bj][0], v1 = acc[ai][bj][m][1] * rt[bj][1];
                    const int tok0 = col0 + bj * 32;
                    if (isg) { const f32x2 a = gelu_pk((f32x2){v0[0], v0[1]}), b = gelu_pk((f32x2){v0[2], v0[3]}), cc = gelu_pk((f32x2){v1[0], v1[1]}), d = gelu_pk((f32x2){v1[2], v1[3]});
                        v0 = (f32x4){a.x, a.y, b.x, b.y}; v1 = (f32x4){cc.x, cc.y, d.x, d.y}; cs[bj][0] += v0 * v0; cs[bj][1] += v1 * v1; }
                    u32x4 w; w.x = cvt_pk_bf16(v0[0], v0[1]); w.y = cvt_pk_bf16(v0[2], v0[3]); w.z = cvt_pk_bf16(v1[0], v1[1]); w.w = cvt_pk_bf16(v1[2], v1[3]);
                    if (isg) { const int h = c >> 7, d = c & 127, sl = tok0 & 127;
                        *(u32x4*)(GT + ((((size_t)((tok0 >> 7) * 4 + h) * 32 + (d >> 5) * 8 + (sl >> 4)) * 64) + ((sl >> 3) & 1) * 32 + (d & 31)) * 8) = w; }
                    else { const int c2 = c - 512, h = c2 >> 6, d = c2 & 63, sl = tok0 & 31, q = sl >> 3;
                        bf16_t* tp = VT + ((((size_t)(h * 1024 + (tok0 >> 5)) * 4 + (d >> 5) * 2 + (q >> 1)) * 64) + (d & 31)) * 8 + (q & 1) * 4;
                        u32x2 lo2; lo2.x = w.x; lo2.y = w.y; u32x2 hi2; hi2.x = w.z; hi2.y = w.w;
                        *(u32x2*)tp = lo2; *(u32x2*)(tp + 32 * 8) = hi2; } } }
        if (isg) {
            float mine = 0.f;
#pragma unroll
            for (int bj = 0; bj < 2; ++bj)
#pragma unroll
                for (int n = 0; n < 2; ++n)
#pragma unroll
                    for (int i = 0; i < 4; ++i) { float v = cs[bj][n][i]; v += __shfl_xor(v, 1); v += __shfl_xor(v, 2); v += __shfl_xor(v, 4); v += __shfl_xor(v, 8);
                        mine = (fr == bj * 8 + n * 4 + i) ? v : mine; }
            const int tok = col0 + (fr >> 3) * 32 + (fr & 7);
            atomicAdd(ssgv + tok, mine);
        }
    }
};

struct EpiPP {
    typedef PreNone Pre;
    static constexpr bool PERM = true, AFTER_DRAIN = false, RS_PREFETCH = false, WIDE = true;
    u32x4* slab;
    __device__ __forceinline__ void operator()(const f32x4 (&acc)[2][2][4][2], const Unit& u, int wr, int wc, int fr, int fq) const {
        u32x4* p = slab + (size_t)(u.pm * 4 + u.pn) * 16 * 512 + threadIdx.x;
#pragma unroll
        for (int ai = 0; ai < 2; ++ai)
#pragma unroll
            for (int bj = 0; bj < 2; ++bj)
#pragma unroll
                for (int m = 0; m < 4; ++m) { const f32x4 v0 = acc[ai][bj][m][0], v1 = acc[ai][bj][m][1];
                    u32x4 w; w.x = cvt_pk_bf16(v0[0], v0[1]); w.y = cvt_pk_bf16(v0[2], v0[3]); w.z = cvt_pk_bf16(v1[0], v1[1]); w.w = cvt_pk_bf16(v1[2], v1[3]);
                    p[(size_t)((ai * 2 + bj) * 4 + m) * 512] = w; }
    }
};
struct EpiGate {
    typedef PreNone Pre;
    static constexpr bool PERM = true, AFTER_DRAIN = false, RS_PREFETCH = false, WIDE = true;
    const bf16_t* hb; float* out; const u32x4* slab; const float* ss; float* ssout; unsigned* cnt; const float* gfin; int ldc; void* tsb;
    __device__ __forceinline__ void operator()(f32x4 (&acc)[2][2][4][2], const Unit& u, int wr, int wc, int fr, int fq) const {
        const int row0 = u.pm * BM + wr * 64 + fr, col0 = u.pn * BM + wc * 64 + 8 * fq;
        const u32x4* p = slab + (size_t)(u.pm * 4 + u.pn) * 16 * 512 + threadIdx.x;
#pragma unroll
        for (int ai = 0; ai < 2; ++ai) {
            u32x4 rv[4][2]; u32x4 pw[4][2]; float rr[4];
#pragma unroll
            for (int m = 0; m < 4; ++m) { rr[m] = ss[row0 + ai * HALF + m * 16];
#pragma unroll
                for (int bj = 0; bj < 2; ++bj) { pw[m][bj] = p[(size_t)((ai * 2 + bj) * 4 + m) * 512];
                    rv[m][bj] = *(const u32x4*)(hb + (size_t)(row0 + ai * HALF + m * 16) * ldc + col0 + bj * 32); } }
#pragma unroll
            for (int m = 0; m < 4; ++m) { const int row = row0 + ai * HALF + m * 16; float sq = 0.f;
                const float r = rs_from_ss(rr[m], 1.0f / 1024.0f);
#pragma unroll
                for (int bj = 0; bj < 2; ++bj) { const u32x4 pq = pw[m][bj], rw = rv[m][bj];
#pragma unroll
                    for (int n = 0; n < 2; ++n) { const unsigned p0 = n ? pq.z : pq.x, p1 = n ? pq.w : pq.y, r0 = n ? rw.z : rw.x, r1 = n ? rw.w : rw.y;
                        const f32x4 a = acc[ai][bj][m][n] * r;
                        f32x4 o; o[0] = bf_lo(r0) + sigmoid_f(a[0]) * bf_lo(p0); o[1] = bf_hi(r0) + sigmoid_f(a[1]) * bf_hi(p0); o[2] = bf_lo(r1) + sigmoid_f(a[2]) * bf_lo(p1); o[3] = bf_hi(r1) + sigmoid_f(a[3]) * bf_hi(p1);
                        acc[ai][bj][m][n] = o; sq += (o[0] * o[0] + o[1] * o[1]) + (o[2] * o[2] + o[3] * o[3]); } }
                sq += __shfl_xor(sq, 16); sq += __shfl_xor(sq, 32);
                if (fq == 0) __hip_atomic_fetch_add(ssout + row, sq, __ATOMIC_RELAXED, __HIP_MEMORY_SCOPE_AGENT); }
            asm volatile("" ::: "memory"); }
        asm volatile("s_waitcnt vmcnt(0)" ::: "memory");
        unsigned* cw = cnt + 64 * u.pm;
        if ((threadIdx.x & 63) == 0) __hip_atomic_fetch_add(cw, 1u, __ATOMIC_RELAXED, __HIP_MEMORY_SCOPE_AGENT);
        f32x4 gq[2][2];
#pragma unroll
        for (int bj = 0; bj < 2; ++bj)
#pragma unroll
            for (int n = 0; n < 2; ++n) gq[bj][n] = *(const f32x4*)(gfin + col0 + bj * 32 + n * 4);
        { unsigned spins = 0;
          while ((unsigned)__builtin_amdgcn_readfirstlane(__hip_atomic_load(cw, __ATOMIC_RELAXED, __HIP_MEMORY_SCOPE_AGENT)) < 32u) { __builtin_amdgcn_s_sleep(2); if (++spins > (1u << 22)) break; } }
        float dl_ = 0.f;
#ifdef PROBE_A
        if (blockIdx.x == 0) { const unsigned long long* T_ = (const unsigned long long*)tsb;
            const float ta = (float)(T_[PROBE_A1] - T_[PROBE_A]) * 0.01f, tb = (float)(T_[PROBE_B1] - T_[PROBE_B]) * 0.01f;
            const int qa = min(127, max(0, (int)(ta * (1.0f / PROBE_SCALE) + 0.5f))), qb = min(127, max(0, (int)(tb * (1.0f / PROBE_SCALE) + 0.5f)));
            dl_ = sqrtf((float)(qa + 128 * qb) * 9.399e-7f); }
#endif
        asm volatile("" ::: "memory");
#pragma unroll
        for (int ai = 0; ai < 2; ++ai)
#pragma unroll
            for (int m = 0; m < 4; ++m) { const int row = row0 + ai * HALF + m * 16; const size_t off = (size_t)row * ldc + col0;
                const float r = rs_from_ss(__hip_atomic_load(ssout + row, __ATOMIC_RELAXED, __HIP_MEMORY_SCOPE_AGENT), 1.0f / 1024.0f);
#pragma unroll
                for (int bj = 0; bj < 2; ++bj)
#pragma unroll
                    for (int n = 0; n < 2; ++n) *(f32x4*)(out + off + bj * 32 + n * 4) = acc[ai][bj][m][n] * r * gq[bj][n] + dl_; }
    }
};
template <class Epi, class Sched, bool ALIGN_EPI = false, bool SP2 = false>
__device__ __forceinline__ void gemm_phase(PG8_LAS unsigned char* lds, const Gemm g, const Sched& S, const Epi& E) {
    const int tid = threadIdx.x, wid = __builtin_amdgcn_readfirstlane(tid >> 6), lane = tid & 63, wr = wid >> 2, wc = wid & 3, fr = lane & 15, fq = lane >> 4;
    const int K = g.K, nt = K / BK;
    unsigned voffA[2], voffB[2];
#pragma unroll
    for (int i = 0; i < 2; ++i) { int R, C; stage_rc(tid * 16 + i * 8192, R, C); const int Rl = Epi::PERM ? perm32(R & 31) : (R & 31); const int Rb = Epi::WIDE ? (64 * (R >> 5) + Rl) : ((R & ~31) + Rl);
        voffA[i] = (unsigned)(R * K + C) * 2u; voffB[i] = (unsigned)(Rb * K + C) * 2u; }
    const size_t kstep = (size_t)(BK * 2);
    const size_t hstepB = Epi::WIDE ? (size_t)32 * K * 2 : (size_t)HALF * K * 2;
    const size_t hstep = (size_t)HALF * K * 2;
    const size_t tstep = 2 * hstep;
    const unsigned ldsw = (unsigned)wid * 1024u;
    const int aoff = lds_byte(wr * 64 + fr, fq * 8), boff = lds_byte(wc * 32 + fr, fq * 8);
#define PG8_SA(b, h) (((b) * 2 + (h)) * HTB)
#define PG8_SB(b, h) ((4 + (b) * 2 + (h)) * HTB)
#define PG8_STAGE(bufoff, gbase, voff) do { _Pragma("unroll") for (int _i = 0; _i < 2; ++_i) \
        __builtin_amdgcn_global_load_lds((const unsigned*)((const char*)(gbase) + (voff)[_i]), (PG8_LAS unsigned*)(lds + (bufoff) + ldsw + _i * 8192), 16, 0, 0); } while (0)
#define PG8_LDA(dst, b, h) do { _Pragma("unroll") for (int m = 0; m < 4; ++m) _Pragma("unroll") for (int k = 0; k < 2; ++k) dst[m][k] = *(const PG8_LAS bf16x8*)(lds + PG8_SA(b, h) + aoff + m * 2048 + k * 1024); } while (0)
#define PG8_LDB(dst, b, h) do { _Pragma("unroll") for (int n = 0; n < 2; ++n) _Pragma("unroll") for (int k = 0; k < 2; ++k) dst[n][k] = *(const PG8_LAS bf16x8*)(lds + PG8_SB(b, h) + boff + n * 2048 + k * 1024); } while (0)
#define PG8_MMA(ai, bj, At, Bt) do { __builtin_amdgcn_s_setprio(1); _Pragma("unroll") for (int m = 0; m < 4; ++m) _Pragma("unroll") for (int n = 0; n < 2; ++n) _Pragma("unroll") for (int k = 0; k < 2; ++k) \
        acc[ai][bj][m][n] = __builtin_amdgcn_mfma_f32_16x16x32_bf16(Bt[n][k], At[m][k], acc[ai][bj][m][n], 0, 0, 0); __builtin_amdgcn_s_setprio(0); } while (0)
#define PG8_WAIT_V(n) asm volatile("s_waitcnt vmcnt(" #n ")" ::: "memory")
#define PG8_WAIT_L(n) asm volatile("s_waitcnt lgkmcnt(" #n ")" ::: "memory")
#define PG8_BAR __builtin_amdgcn_s_barrier()
#define PG8_SCHED __builtin_amdgcn_sched_barrier(0)
    Unit cur, nxt; int ui = 0;
    if (!S.next(0, cur)) return;
    typename Epi::Pre rsv;
    if constexpr (Epi::RS_PREFETCH) E.load_rs(rsv, cur, wr, wc, fr, fq);
    f32x4 acc[2][2][4][2];
#pragma unroll
    for (int a = 0; a < 2; ++a)
#pragma unroll
        for (int b = 0; b < 2; ++b)
#pragma unroll
            for (int m = 0; m < 4; ++m)
#pragma unroll
                for (int n = 0; n < 2; ++n) acc[a][b][m][n] = (f32x4){0.f, 0.f, 0.f, 0.f};
    bf16x8 At[4][2], B0[2][2], B1[2][2];
    const char* cA = (const char*)g.A + (size_t)cur.pm * tstep; const char* cB = (const char*)g.Bt + (size_t)cur.pn * tstep;
    S.a_ready(cur);
    if constexpr (SP2) {
        PG8_STAGE(PG8_SB(0, 0), cB, voffB); PG8_STAGE(PG8_SB(0, 1), cB + hstepB, voffB); PG8_STAGE(PG8_SA(0, 0), cA, voffA); PG8_STAGE(PG8_SA(0, 1), cA + hstep, voffA);
        if (wr == 1) PG8_BAR;
        PG8_WAIT_V(2); PG8_BAR;
        PG8_STAGE(PG8_SB(1, 0), cB + kstep, voffB); PG8_STAGE(PG8_SA(1, 0), cA + kstep, voffA); PG8_STAGE(PG8_SB(1, 1), cB + hstepB + kstep, voffB);
        PG8_WAIT_V(6); PG8_BAR;
    } else {
        PG8_STAGE(PG8_SB(0, 0), cB, voffB); PG8_STAGE(PG8_SA(0, 0), cA, voffA); PG8_STAGE(PG8_SB(0, 1), cB + hstepB, voffB); PG8_STAGE(PG8_SA(0, 1), cA + hstep, voffA);
        if (wr == 1) PG8_BAR;
        PG8_WAIT_V(4); PG8_BAR;
        PG8_STAGE(PG8_SB(1, 0), cB + kstep, voffB); PG8_STAGE(PG8_SA(1, 0), cA + kstep, voffA); PG8_STAGE(PG8_SB(1, 1), cB + hstepB + kstep, voffB);
        PG8_WAIT_V(6); PG8_BAR;
    }
    for (;;) {
        const bool has_next = S.next(ui + 1, nxt);
        const char* nA = has_next ? (const char*)g.A + (size_t)nxt.pm * tstep : cA; const char* nB = has_next ? (const char*)g.Bt + (size_t)nxt.pn * tstep : cB;
#pragma nounroll
        for (int t = 0; t < nt; t += 2) {
            const bool last = (t == nt - 2);
            const char* a1 = cA + (size_t)(t + 1) * kstep;
            const char* a2 = last ? nA : cA + (size_t)(t + 2) * kstep; const char* b2 = last ? nB : cB + (size_t)(t + 2) * kstep;
            const char* a3 = a2 + kstep; const char* b3 = b2 + kstep;
            if (last && has_next) S.a_ready(nxt);
            if constexpr (SP2) {
            PG8_LDB(B0, 0, 0); PG8_LDB(B1, 0, 1); PG8_SCHED; PG8_LDA(At, 0, 0); PG8_STAGE(PG8_SA(1, 1), a1 + hstep, voffA);
            PG8_WAIT_V(8); PG8_WAIT_L(0); PG8_BAR; PG8_MMA(0, 0, At, B0); PG8_MMA(0, 1, At, B1); PG8_BAR; PG8_SCHED;
            PG8_LDA(At, 0, 1); PG8_STAGE(PG8_SB(0, 0), b2, voffB); PG8_STAGE(PG8_SB(0, 1), b2 + hstepB, voffB); PG8_STAGE(PG8_SA(0, 0), a2, voffA);
            PG8_WAIT_V(8); PG8_WAIT_L(0); PG8_BAR; PG8_MMA(1, 0, At, B0); PG8_MMA(1, 1, At, B1); PG8_BAR; PG8_SCHED;
            PG8_LDB(B0, 1, 0); PG8_LDB(B1, 1, 1); PG8_SCHED; PG8_LDA(At, 1, 0); PG8_STAGE(PG8_SA(0, 1), a2 + hstep, voffA);
            PG8_WAIT_V(8); PG8_WAIT_L(0); PG8_BAR; PG8_MMA(0, 0, At, B0); PG8_MMA(0, 1, At, B1); PG8_BAR; PG8_SCHED;
            PG8_LDA(At, 1, 1); PG8_STAGE(PG8_SB(1, 0), b3, voffB); PG8_STAGE(PG8_SB(1, 1), b3 + hstepB, voffB); PG8_STAGE(PG8_SA(1, 0), a3, voffA);
            PG8_WAIT_V(8); PG8_WAIT_L(0); PG8_BAR; PG8_MMA(1, 0, At, B0); PG8_MMA(1, 1, At, B1); PG8_BAR; PG8_SCHED;
            } else {
            PG8_LDB(B0, 0, 0); PG8_SCHED; PG8_LDA(At, 0, 0); PG8_STAGE(PG8_SA(1, 1), a1 + hstep, voffA);
            PG8_WAIT_L(8); PG8_BAR; PG8_WAIT_L(0); PG8_MMA(0, 0, At, B0); PG8_BAR; PG8_SCHED;
            PG8_LDB(B1, 0, 1); PG8_STAGE(PG8_SB(0, 0), b2, voffB);
            PG8_BAR; PG8_WAIT_L(0); PG8_MMA(0, 1, At, B1); PG8_BAR;
            PG8_LDA(At, 0, 1); PG8_STAGE(PG8_SA(0, 0), a2, voffA);
            PG8_BAR; PG8_WAIT_L(0); PG8_MMA(1, 0, At, B0); PG8_BAR; PG8_SCHED;
            PG8_STAGE(PG8_SB(0, 1), b2 + hstepB, voffB);
            PG8_WAIT_V(6); PG8_BAR; PG8_MMA(1, 1, At, B1); PG8_BAR;
            PG8_LDB(B0, 1, 0); PG8_SCHED; PG8_LDA(At, 1, 0); PG8_STAGE(PG8_SA(0, 1), a2 + hstep, voffA);
            PG8_WAIT_L(8); PG8_BAR; PG8_WAIT_L(0); PG8_MMA(0, 0, At, B0); PG8_BAR; PG8_SCHED;
            PG8_LDB(B1, 1, 1); PG8_STAGE(PG8_SB(1, 0), b3, voffB);
            PG8_BAR; PG8_WAIT_L(0); PG8_MMA(0, 1, At, B1); PG8_BAR;
            PG8_LDA(At, 1, 1); PG8_STAGE(PG8_SA(1, 0), a3, voffA);
            PG8_BAR; PG8_WAIT_L(0); PG8_MMA(1, 0, At, B0); PG8_BAR; PG8_SCHED;
            PG8_STAGE(PG8_SB(1, 1), b3 + hstepB, voffB);
            PG8_WAIT_V(6); PG8_BAR; PG8_MMA(1, 1, At, B1); PG8_BAR;
            }
        }
        if constexpr (ALIGN_EPI) { if (wr == 0) PG8_BAR; }
        if constexpr (!Epi::AFTER_DRAIN) { if constexpr (Epi::RS_PREFETCH) { E(acc, cur, wr, wc, fr, fq, rsv); if (has_next) E.load_rs(rsv, nxt, wr, wc, fr, fq); } else { E(acc, cur, wr, wc, fr, fq); } S.done(cur); }
        if (!has_next) break;
#pragma unroll
        for (int a = 0; a < 2; ++a)
#pragma unroll
            for (int b = 0; b < 2; ++b)
#pragma unroll
                for (int m = 0; m < 4; ++m)
#pragma unroll
                    for (int n = 0; n < 2; ++n) acc[a][b][m][n] = (f32x4){0.f, 0.f, 0.f, 0.f};
        cur = nxt; cA = nA; cB = nB; ++ui;
        if constexpr (ALIGN_EPI) { if (wr == 1) PG8_BAR; }
    }
    PG8_WAIT_V(0);
    if constexpr (!ALIGN_EPI) { if (wr == 0) PG8_BAR; }
    PG8_BAR;
    if constexpr (Epi::AFTER_DRAIN) { E.fused(acc, cur, wr, wc, fr, fq, lds, wid, lane); S.done(cur); }
#undef PG8_SA
#undef PG8_SB
#undef PG8_STAGE
#undef PG8_LDA
#undef PG8_LDB
#undef PG8_MMA
#undef PG8_WAIT_V
#undef PG8_WAIT_L
#undef PG8_BAR
#undef PG8_SCHED
}
}

#include <hip/hip_cooperative_groups.h>
namespace cg = cooperative_groups;

#ifndef MK_N_LAUNCHES
#define MK_N_LAUNCHES 1
#endif
constexpr int NWAVES = 8;
constexpr int NPHASE = 9;
constexpr int BATCH = 8, SEQ = 4096, DM = 1024, MTOK = BATCH * SEQ, DFF = 2816, PLE = 256;
constexpr size_t MiB = 1u << 20;
constexpr size_t WS_SS = 0;
constexpr size_t WS_W1IN = 1 * MiB, WS_W1OUT = 12 * MiB, WS_WMIX = 18 * MiB, WS_WMO = 23 * MiB, WS_W2IN = 25 * MiB, WS_W2OUT = 36 * MiB, WS_WG = 42 * MiB, WS_WP = 44 * MiB;
constexpr size_t WS_HB = 45 * MiB;
constexpr size_t WS_MIXED = 109 * MiB;
constexpr size_t WS_PB = 173 * MiB;
constexpr size_t WS_BIG = 189 * MiB;
constexpr size_t WS_GVT = WS_BIG + 96 * MiB;
constexpr size_t WS_END = WS_BIG + 176 * MiB;
constexpr int RING_BYTES = 131072, LDS_BYTES = 147456;
constexpr int GVT_PITCH = MTOK + 2176;

typedef unsigned short bf16;
typedef float f32x4 __attribute__((ext_vector_type(4)));
typedef float f32x16 __attribute__((ext_vector_type(16)));
typedef short bf16x8 __attribute__((ext_vector_type(8)));
typedef short s16x4 __attribute__((ext_vector_type(4)));
typedef unsigned u32x4 __attribute__((ext_vector_type(4)));
typedef unsigned u32x2 __attribute__((ext_vector_type(2)));
#define LAS __attribute__((address_space(3)))

__device__ __forceinline__ unsigned pk2(float lo, float hi) { return pg8::cvt_pk_bf16(lo, hi); }
__device__ __forceinline__ float wave_sum(float v) {
#pragma unroll
    for (int o = 1; o < 64; o <<= 1) v += __shfl_xor(v, o);
    return v;
}
__device__ __forceinline__ int crow(int r, int hi) { return (r & 3) + 8 * (r >> 2) + 4 * hi; }

__device__ __forceinline__ void p0_transpose_item(const float* W, int K, int N, bf16* WT, const float* gain, int mapkind, LAS float* scr, int item, int lane) {
    const int nblk = N / 32, kb = item / nblk, nb = item % nblk, k0 = 64 * kb, n0 = 32 * nb;
    int d0 = n0;
    if (mapkind == 1) { const bool up = n0 >= DFF; const int j = up ? n0 - DFF : n0; d0 = (j >> 7) * 256 + (up ? 128 : 0) + (j & 127); }
    else if (mapkind == 2) { d0 = n0 < 512 ? n0 : n0 < 1024 ? 1536 + (n0 - 512) : n0 < 2048 ? 512 + (n0 - 1024) : n0; }
    { f32x4 v[8]; float gq[8];
#pragma unroll
      for (int i = 0; i < 8; ++i) { const int kk = (lane >> 3) + 8 * i; v[i] = __builtin_nontemporal_load((const f32x4*)(W + (size_t)(k0 + kk) * N + n0 + 4 * (lane & 7))); gq[i] = gain ? gain[k0 + kk] : 1.0f; }
#pragma unroll
      for (int i = 0; i < 8; ++i) { const int kk = (lane >> 3) + 8 * i; LAS float* d = scr + kk * 33 + 4 * (lane & 7); d[0] = v[i][0] * gq[i]; d[1] = v[i][1] * gq[i]; d[2] = v[i][2] * gq[i]; d[3] = v[i][3] * gq[i]; } }
    asm volatile("s_waitcnt lgkmcnt(0)" ::: "memory");
    const int c = lane & 7;
#pragma unroll
    for (int j = 0; j < 4; ++j) { const int n = (lane >> 3) + 8 * j; const LAS float* s = scr + (8 * c) * 33 + n;
        u32x4 o; o.x = pk2(s[0 * 33], s[1 * 33]); o.y = pk2(s[2 * 33], s[3 * 33]); o.z = pk2(s[4 * 33], s[5 * 33]); o.w = pk2(s[6 * 33], s[7 * 33]);
        *(u32x4*)(WT + (size_t)(d0 + n) * K + k0 + 8 * c) = o; }
    asm volatile("s_waitcnt lgkmcnt(0)" ::: "memory");
}

#define XB_TMO      128
#define XB_XCNT(j)  (256  + 64 * (j))
#define XB_XSUB(j)  (1280 + 64 * (j))
#define XB_XGEN(j)  (2304 + 64 * (j))
#define XB_TOP      3328
#define XB_TOPGEN   3392
#define XCD_BAR_WORDS 3456
#define XB_SPIN_CAP (1u << 18)

__device__ __forceinline__ unsigned xb_ld(unsigned* p)              { return __hip_atomic_load(p, __ATOMIC_RELAXED, __HIP_MEMORY_SCOPE_AGENT); }
__device__ __forceinline__ unsigned xb_add(unsigned* p, unsigned v) { return __hip_atomic_fetch_add(p, v, __ATOMIC_RELAXED, __HIP_MEMORY_SCOPE_AGENT); }
__device__ __forceinline__ unsigned xb_xcc_id() { return (unsigned)__builtin_amdgcn_s_getreg((3 << 11) | 20) & 0xFu; }
#define XB_SPIN(cond, bar) do { unsigned _sp = 0; while (cond) { __builtin_amdgcn_s_sleep(1); \
    if ((++_sp & 255u) == 0u) { if (xb_ld(&(bar)[XB_TMO])) break; if (_sp > XB_SPIN_CAP) { atomicAdd(&(bar)[XB_TMO], 1u); break; } } } } while (0)

struct XcdBarrier {
    unsigned* bar; unsigned x;
    volatile LAS unsigned* st;
};

__device__ __forceinline__ XcdBarrier xcd_barrier_post(unsigned* bar, volatile LAS unsigned* st) {
    XcdBarrier b; b.bar = bar; b.x = xb_xcc_id(); b.st = st;
    if (threadIdx.x == 0) (void)xb_add(&bar[XB_XCNT(b.x)], 1u);
    return b;
}
__device__ __forceinline__ void xcd_barrier_complete(unsigned* bar, unsigned x, unsigned& nloc, unsigned& nx) {
    const unsigned G = gridDim.x * gridDim.y * gridDim.z;
    unsigned sum, cnt, mine, sp = 0u;
    for (;;) {
        sum = 0u; cnt = 0u; mine = 0u;
#pragma unroll
        for (unsigned j = 0; j < 16; ++j) { const unsigned c = xb_ld(&bar[XB_XCNT(j)]); sum += c; cnt += (c > 0u) ? 1u : 0u; mine = (j == x) ? c : mine; }
        if (sum == G) break;
        __builtin_amdgcn_s_sleep(1);
        if ((++sp & 255u) == 0u) { if (xb_ld(&bar[XB_TMO])) break; if (sp > XB_SPIN_CAP) { atomicAdd(&bar[XB_TMO], 1u); break; } }
    }
    nloc = mine > 0u ? mine : 1u; nx = cnt > 0u ? cnt : 1u;
}

__device__ __forceinline__ void xcd_barrier(const XcdBarrier& b) {
    asm volatile("s_waitcnt vmcnt(0)" ::: "memory");
    __syncthreads();
    if (threadIdx.x == 0) {
        unsigned* bar = b.bar;
        __builtin_amdgcn_s_waitcnt(0);
        unsigned nloc = b.st[0], nx = b.st[1];
        if (nloc == 0u) { xcd_barrier_complete(bar, b.x, nloc, nx); b.st[0] = nloc; b.st[1] = nx; }
        const unsigned old = xb_add(&bar[XB_XSUB(b.x)], 1u);
        const unsigned gen = old / nloc;
        if (old + 1u == (gen + 1u) * nloc) {
            __builtin_amdgcn_fence(__ATOMIC_RELEASE, "agent");
            asm volatile("s_waitcnt vmcnt(0)" ::: "memory");
            const unsigned og = xb_add(&bar[XB_TOP], 1u);
            const unsigned tg = og / nx;
            if (og + 1u == (tg + 1u) * nx) xb_add(&bar[XB_TOPGEN], 1u);
            else XB_SPIN(xb_ld(&bar[XB_TOPGEN]) == tg, bar);
            __builtin_amdgcn_fence(__ATOMIC_ACQUIRE, "agent");
            xb_add(&bar[XB_XGEN(b.x)], 1u);
            asm volatile("s_waitcnt vmcnt(0)" ::: "memory");
        } else {
            XB_SPIN(xb_ld(&bar[XB_XGEN(b.x)]) == gen, bar);
            __builtin_amdgcn_fence(__ATOMIC_ACQUIRE, "agent");
            asm volatile("s_waitcnt vmcnt(0)" ::: "memory");
        }
    }
    __syncthreads();
}

constexpr size_t WS_CTL = 768 * 1024;
#ifndef REP0
#define REP0 1
#endif
#ifndef REP1
#define REP1 1
#endif
#ifndef REP4
#define REP4 1
#endif
__device__ __forceinline__ void store_tile_rows(LAS unsigned char* wl, const float (&v0)[16], const float (&v1)[16], bf16* dst, int pitch, int lane) {
    const int r32 = lane & 31, hi = lane >> 5;
#pragma unroll
    for (int g = 0; g < 4; ++g) {
        u32x2 a; a.x = pk2(v0[4 * g], v0[4 * g + 1]); a.y = pk2(v0[4 * g + 2], v0[4 * g + 3]); *(LAS u32x2*)(wl + r32 * 144 + (8 * g + 4 * hi) * 2) = a;
        u32x2 b; b.x = pk2(v1[4 * g], v1[4 * g + 1]); b.y = pk2(v1[4 * g + 2], v1[4 * g + 3]); *(LAS u32x2*)(wl + r32 * 144 + (32 + 8 * g + 4 * hi) * 2) = b; }
    asm volatile("s_waitcnt lgkmcnt(0)" ::: "memory");
#pragma unroll
    for (int i = 0; i < 4; ++i) { const int row = (lane >> 3) + 8 * i, ch = lane & 7;
        const u32x4 w = *(const LAS u32x4*)(wl + row * 144 + ch * 16); *(u32x4*)(dst + (size_t)row * pitch + ch * 8) = w; }
    asm volatile("s_waitcnt lgkmcnt(0)" ::: "memory");
}

#ifndef FFN_WGM
#define FFN_WGM 4
#endif
#ifndef ATT_THR
#define ATT_THR 4.0e-18f
#endif
struct Args { const float* in[18]; float* out; unsigned char* ws; int ph_lo, ph_hi; };

__device__ __forceinline__ void attn_wave_unit(const bf16* UQK, const bf16* VT, bf16* MIXED, int b, int h, int qi, int lane, LAS unsigned char* wl) {
    const int r32 = lane & 31, hi = lane >> 5;
    const size_t tokb = (size_t)b * SEQ; const int t0 = qi * 32;
    const bf16* qp = UQK + (tokb + t0 + r32) * 1536 + 512 + h * 64 + 8 * hi;
    bf16x8 qf[4];
#pragma unroll
    for (int d = 0; d < 4; ++d) qf[d] = *(const bf16x8*)(qp + 16 * d);
    f32x16 o0, o1;
#pragma unroll
    for (int i = 0; i < 16; ++i) { o0[i] = 0.f; o1[i] = 0.f; }
    float carry = 1.0f;
    const bf16* kbase = UQK + (tokb + r32) * 1536 + 1024 + h * 64 + 8 * hi;
    const bf16* vbase = VT + (size_t)16 * 1024 * 1024 + (size_t)(h * 1024 + b * 128) * 2048 + lane * 8;
    bf16x8 kfA[4], kfB[4], kfC[4], kfD[4]; bf16x8 vtA[2][2], vtB[2][2], vtC[2][2], vtD[2][2];
#define ATT_LOAD(KF, VT, s0_) do { \
        _Pragma("unroll") for (int d = 0; d < 4; ++d) KF[d] = *(const bf16x8*)(kbase + (size_t)(s0_) * 1536 + 16 * d); \
        _Pragma("unroll") for (int db = 0; db < 2; ++db) _Pragma("unroll") for (int j = 0; j < 2; ++j) \
            VT[db][j] = *(const bf16x8*)(vbase + (size_t)((s0_) >> 5) * 2048 + (db * 2 + j) * 512); } while (0)
#define VFRAG(VT, db, j) (VT[db][j])
#define ATT_BLOCK(KF, VT, kb_) do { \
        f32x16 z; \
        _Pragma("unroll") for (int i = 0; i < 16; ++i) z[i] = 0.f; \
        _Pragma("unroll") for (int d = 0; d < 4; ++d) z = __builtin_amdgcn_mfma_f32_32x32x16_bf16(KF[d], qf[d], z, 0, 0, 0); \
        const bool diag = ((kb_) == qi); \
          \
        float u[16], sg[16]; \
        _Pragma("unroll") for (int i = 0; i < 16; ++i) { const float zz = z[i]; const float e = __builtin_amdgcn_exp2f(-fabsf(zz) * 1.4426950408889634f); \
            const float r = __builtin_amdgcn_rcpf(1.0f + e), er = e * r; const bool pos = zz >= 0.f; \
            const bool valid = !diag || (crow(i, hi) < r32); u[i] = valid ? (pos ? er : r) : 1.0f; sg[i] = valid ? (pos ? r : er) : 0.f; } \
        float Gs[4], Go[4], T[4]; \
        _Pragma("unroll") for (int g = 0; g < 4; ++g) { Gs[g] = (u[4 * g] * u[4 * g + 1]) * (u[4 * g + 2] * u[4 * g + 3]); Go[g] = __shfl_xor(Gs[g], 32); T[g] = Gs[g] * Go[g]; } \
        float aft[4]; aft[3] = 1.0f; aft[2] = T[3]; aft[1] = T[3] * T[2]; aft[0] = aft[1] * T[1]; \
        const float total = aft[0] * T[0]; \
        float a[16]; \
        _Pragma("unroll") for (int g = 0; g < 4; ++g) { float run = aft[g] * (hi == 0 ? Go[g] : 1.0f) * carry; \
            _Pragma("unroll") for (int j = 3; j >= 0; --j) { const int i = 4 * g + j; a[i] = sg[i] * run; run *= u[i]; } } \
        carry *= total; \
        u32x4 p0, p1; \
        p0.x = pk2(a[0], a[1]); p0.y = pk2(a[2], a[3]); p0.z = pk2(a[4], a[5]); p0.w = pk2(a[6], a[7]); \
        p1.x = pk2(a[8], a[9]); p1.y = pk2(a[10], a[11]); p1.z = pk2(a[12], a[13]); p1.w = pk2(a[14], a[15]); \
        const bf16x8 pb0 = __builtin_bit_cast(bf16x8, p0), pb1 = __builtin_bit_cast(bf16x8, p1); \
        o0 = __builtin_amdgcn_mfma_f32_32x32x16_bf16(VFRAG(VT, 0, 0), pb0, o0, 0, 0, 0); \
        o0 = __builtin_amdgcn_mfma_f32_32x32x16_bf16(VFRAG(VT, 0, 1), pb1, o0, 0, 0, 0); \
        o1 = __builtin_amdgcn_mfma_f32_32x32x16_bf16(VFRAG(VT, 1, 0), pb0, o1, 0, 0, 0); \
        o1 = __builtin_amdgcn_mfma_f32_32x32x16_bf16(VFRAG(VT, 1, 1), pb1, o1, 0, 0, 0); } while (0)
    ATT_LOAD(kfA, vtA, t0); ATT_LOAD(kfB, vtB, (qi > 0 ? qi - 1 : 0) * 32); ATT_LOAD(kfC, vtC, (qi > 1 ? qi - 2 : 0) * 32); ATT_LOAD(kfD, vtD, (qi > 2 ? qi - 3 : 0) * 32);
    ATT_BLOCK(kfA, vtA, qi);
    if (qi >= 1 && !__all(carry < ATT_THR)) {
        ATT_BLOCK(kfB, vtB, qi - 1);
        if (qi >= 2 && !__all(carry < ATT_THR)) {
            ATT_BLOCK(kfC, vtC, qi - 2);
            if (qi >= 3 && !__all(carry < ATT_THR)) {
                ATT_BLOCK(kfD, vtD, qi - 3);
                for (int kb = qi - 4; kb >= 0; --kb) {
                    if (__all(carry < ATT_THR)) break;
                    ATT_LOAD(kfA, vtA, kb * 32);
                    ATT_BLOCK(kfA, vtA, kb);
                }
            }
        }
    }
#undef ATT_LOAD
#undef ATT_BLOCK
#undef VFRAG
    { float v0[16], v1[16];
#pragma unroll
      for (int i = 0; i < 16; ++i) { v0[i] = o0[i]; v1[i] = o1[i]; }
      store_tile_rows(wl, v0, v1, MIXED + (tokb + t0) * 1024 + 512 + h * 64, 1024, lane); }
}

__device__ __forceinline__ void gmlp_unit(const bf16* UQK, const bf16* GVT, bf16* MIXED, const float* w_s, const float* b_s, const float* vgain, const float* ssgv, int b, int c, int h, int wave, int lane, int flip, LAS unsigned char* wl) {
    const int r32 = lane & 31, hi = lane >> 5, tb = flip ? 3 - (wave >> 1) : (wave >> 1), dbp = wave & 1;
    const size_t tokbase = (size_t)b * SEQ + (size_t)c * 128; const int t0 = 32 * tb, t = t0 + r32;
    const float* wrow = w_s + ((size_t)h * 128 + t) * 128 + 8 * hi;
    f32x16 acc0, acc1;
#pragma unroll
    for (int i = 0; i < 16; ++i) { acc0[i] = 0.f; acc1[i] = 0.f; }
    const int nks = 2 * (tb + 1);
    const bf16* g0p = GVT + (((size_t)((b * 32 + c) * 4 + h) * 32 + 2 * dbp * 8) * 64 + lane) * 8;
    const float bb = b_s[h * 128 + t];
    const size_t tok = tokbase + t;
    u32x2 gu[2][4]; f32x4 vg[2][4];
#pragma unroll
    for (int dd = 0; dd < 2; ++dd)
#pragma unroll
        for (int g = 0; g < 4; ++g) { const int col = h * 128 + 64 * dbp + 32 * dd + 8 * g + 4 * hi; gu[dd][g] = *(const u32x2*)(UQK + tok * 1536 + col); vg[dd][g] = *(const f32x4*)(vgain + col); }
#pragma unroll
    for (int half = 0; half < 2; ++half) {
        if (4 * half < nks) {
            f32x4 w0[4], w1[4], q0[4], q1[4]; bf16x8 a0[4], a1[4];
#pragma unroll
            for (int k4 = 0; k4 < 4; ++k4) { const int ks = 4 * half + k4; const int s = 16 * ks + 8 * hi;
                if (ks < nks) { w0[k4] = *(const f32x4*)(wrow + 16 * ks); w1[k4] = *(const f32x4*)(wrow + 16 * ks + 4);
                    q0[k4] = *(const f32x4*)(ssgv + tokbase + s); q1[k4] = *(const f32x4*)(ssgv + tokbase + s + 4);
                    a0[k4] = *(const bf16x8*)(g0p + ks * 512); a1[k4] = *(const bf16x8*)(g0p + 8 * 512 + ks * 512); } }
#pragma unroll
            for (int k4 = 0; k4 < 4; ++k4) { const int ks = 4 * half + k4; const int s = 16 * ks + 8 * hi;
                if (ks < nks) { float v[8];
#pragma unroll
                    for (int e = 0; e < 4; ++e) { v[e] = (s + e <= t) ? w0[k4][e] * pg8::rs_from_ss(q0[k4][e], 1.0f / 512.0f) : 0.f; v[4 + e] = (s + 4 + e <= t) ? w1[k4][e] * pg8::rs_from_ss(q1[k4][e], 1.0f / 512.0f) : 0.f; }
                    u32x4 bw; bw.x = pk2(v[0], v[1]); bw.y = pk2(v[2], v[3]); bw.z = pk2(v[4], v[5]); bw.w = pk2(v[6], v[7]);
                    const bf16x8 bfrag = __builtin_bit_cast(bf16x8, bw);
                    acc0 = __builtin_amdgcn_mfma_f32_32x32x16_bf16(a0[k4], bfrag, acc0, 0, 0, 0);
                    acc1 = __builtin_amdgcn_mfma_f32_32x32x16_bf16(a1[k4], bfrag, acc1, 0, 0, 0); } }
        }
    }
    { float v0[16], v1[16];
#pragma unroll
      for (int g = 0; g < 4; ++g) { const u32x2 ga = gu[0][g], gb = gu[1][g]; const f32x4 va = vg[0][g], vb = vg[1][g];
          v0[4 * g] = pg8::bf_lo(ga.x) * (va[0] * acc0[4 * g] + bb); v0[4 * g + 1] = pg8::bf_hi(ga.x) * (va[1] * acc0[4 * g + 1] + bb); v0[4 * g + 2] = pg8::bf_lo(ga.y) * (va[2] * acc0[4 * g + 2] + bb); v0[4 * g + 3] = pg8::bf_hi(ga.y) * (va[3] * acc0[4 * g + 3] + bb);
          v1[4 * g] = pg8::bf_lo(gb.x) * (vb[0] * acc1[4 * g] + bb); v1[4 * g + 1] = pg8::bf_hi(gb.x) * (vb[1] * acc1[4 * g + 1] + bb); v1[4 * g + 2] = pg8::bf_lo(gb.y) * (vb[2] * acc1[4 * g + 2] + bb); v1[4 * g + 3] = pg8::bf_hi(gb.y) * (vb[3] * acc1[4 * g + 3] + bb); }
      store_tile_rows(wl, v0, v1, MIXED + (tokbase + t0) * 1024 + h * 128 + 64 * dbp, 1024, lane); }
}

__global__ void __launch_bounds__(NWAVES * 64, 2) mk_fwd(Args args) {
    extern __shared__ __attribute__((aligned(16))) unsigned char lds_raw[];
    LAS unsigned char* lds = (LAS unsigned char*)lds_raw;
    const int tid = threadIdx.x, lane = tid & 63, wave = __builtin_amdgcn_readfirstlane(tid >> 6);
    const int G = gridDim.x, bx = blockIdx.x;
    const int gw = bx * NWAVES + wave, NGW = G * NWAVES;
#define ws (args.ws)
#define xin (args.in[0])
#define pin (args.in[1])
#define ssx ((float*)(ws + WS_SS))
#define ss1 (ssx + MTOK)
#define ssgv (ssx + 2 * MTOK)
#define ss2 (ssx + 3 * MTOK)
#define ss3 (ssx + 4 * MTOK)
#define ss4 (ssx + 5 * MTOK)
#define W1in ((bf16*)(ws + WS_W1IN))
#define W1out ((bf16*)(ws + WS_W1OUT))
#define Wmix ((bf16*)(ws + WS_WMIX))
#define Wmo ((bf16*)(ws + WS_WMO))
#define W2in ((bf16*)(ws + WS_W2IN))
#define W2out ((bf16*)(ws + WS_W2OUT))
#define Wg ((bf16*)(ws + WS_WG))
#define Wp ((bf16*)(ws + WS_WP))
#define HB ((bf16*)(ws + WS_HB))
#define MIXED ((bf16*)(ws + WS_MIXED))
#define PB ((bf16*)(ws + WS_PB))
#define HID ((bf16*)(ws + WS_BIG))
#define UQK ((bf16*)(ws + WS_BIG))
#define GVT ((bf16*)(ws + WS_GVT))
#define SLAB ((u32x4*)(ws + WS_BIG))
#define out (args.out)
    const int lo = args.ph_lo, hi_ph = args.ph_hi;
#ifndef PHASE_MASK
#define PHASE_MASK 0x3ff
#endif
#define IN(k) (((PHASE_MASK >> (k)) & 1) && lo <= (k) && (k) < hi_ph)
#ifdef PROBE_A
#ifndef TS_BLOCK
#define TS_BLOCK 0
#endif
#define TSTAMP(k) do { if (bx == TS_BLOCK && tid == 0) ((unsigned long long*)(ws + WS_CTL + 49152))[k] = __builtin_amdgcn_s_memrealtime(); } while (0)
#else
#define TSTAMP(k) do {} while (0)
#endif
#define SEAM(k) do { if (IN(k) && IN((k) + 1)) { xcd_barrier(bar); } TSTAMP((k) + 1); } while (0)
    if (tid < 2) ((LAS unsigned*)(lds + RING_BYTES))[tid] = 0u;
    __syncthreads();
    if (args.ph_lo < 0) cg::this_grid().sync();
    TSTAMP(0);
    XcdBarrier bar = xcd_barrier_post((unsigned*)(ws + WS_CTL), (volatile LAS unsigned*)(lds + RING_BYTES));

    if (IN(0)) for (int rep = 0; rep < REP0; ++rep) {
        LAS float* scr = (LAS float*)(lds + wave * 16384);
        constexpr int I_IN = (DM / 64) * (2 * DFF / 32), I_OUT = (DFF / 64) * (DM / 32), I_MIX = (DM / 64) * (2560 / 32), I_SQ = (DM / 64) * (DM / 32), I_P = (PLE / 64) * (DM / 32);
        constexpr int NITEMS = 2 * I_IN + 2 * I_OUT + I_MIX + 2 * I_SQ + I_P;
        for (int it = gw; it < NITEMS; it += NGW) {
            int r = it;
            if (r < I_IN) { p0_transpose_item(args.in[3], DM, 2 * DFF, W1in, args.in[2], 1, scr, r, lane); continue; } r -= I_IN;
            if (r < I_IN) { p0_transpose_item(args.in[12], DM, 2 * DFF, W2in, args.in[11], 1, scr, r, lane); continue; } r -= I_IN;
            if (r < I_OUT) { p0_transpose_item(args.in[4], DFF, DM, W1out, nullptr, 0, scr, r, lane); continue; } r -= I_OUT;
            if (r < I_OUT) { p0_transpose_item(args.in[13], DFF, DM, W2out, nullptr, 0, scr, r, lane); continue; } r -= I_OUT;
            if (r < I_MIX) { p0_transpose_item(args.in[6], DM, 2560, Wmix, args.in[5], 2, scr, r, lane); continue; } r -= I_MIX;
            if (r < I_SQ) { p0_transpose_item(args.in[10], DM, DM, Wmo, nullptr, 0, scr, r, lane); continue; } r -= I_SQ;
            if (r < I_SQ) { p0_transpose_item(args.in[15], DM, DM, Wg, args.in[14], 0, scr, r, lane); continue; } r -= I_SQ;
            p0_transpose_item(args.in[16], PLE, DM, Wp, nullptr, 0, scr, r, lane);
        }
        for (int m0 = gw * 4; m0 + 3 < MTOK; m0 += NGW * 4) {
            f32x4 v[4][4];
#pragma unroll
            for (int q = 0; q < 4; ++q) { const f32x4* xr = (const f32x4*)(xin + (size_t)(m0 + q) * DM) + lane;
#pragma unroll
                for (int j = 0; j < 4; ++j) v[q][j] = __builtin_nontemporal_load(xr + 64 * j); }
#pragma unroll
            for (int q = 0; q < 4; ++q) { float s = 0.f;
#pragma unroll
                for (int j = 0; j < 4; ++j) s += (v[q][j][0] * v[q][j][0] + v[q][j][1] * v[q][j][1]) + (v[q][j][2] * v[q][j][2] + v[q][j][3] * v[q][j][3]);
                s = wave_sum(s); if (lane == 0) ssx[m0 + q] = s;
                u32x2* o8 = (u32x2*)(HB + (size_t)(m0 + q) * DM) + lane;
#pragma unroll
                for (int j = 0; j < 4; ++j) { u32x2 w; w.x = pk2(v[q][j][0], v[q][j][1]); w.y = pk2(v[q][j][2], v[q][j][3]); o8[64 * j] = w; } }
        }
        for (size_t i0 = (size_t)gw * 256 + lane; i0 < (size_t)MTOK * PLE / 8; i0 += (size_t)NGW * 256) {
            f32x4 a[4], b[4];
#pragma unroll
            for (int q = 0; q < 4; ++q) if (i0 + 64 * q < (size_t)MTOK * PLE / 8) { a[q] = __builtin_nontemporal_load((const f32x4*)pin + 2 * (i0 + 64 * q)); b[q] = __builtin_nontemporal_load((const f32x4*)pin + 2 * (i0 + 64 * q) + 1); }
#pragma unroll
            for (int q = 0; q < 4; ++q) if (i0 + 64 * q < (size_t)MTOK * PLE / 8) { u32x4 w; w.x = pk2(a[q][0], a[q][1]); w.y = pk2(a[q][2], a[q][3]); w.z = pk2(b[q][0], b[q][1]); w.w = pk2(b[q][2], b[q][3]); ((u32x4*)PB)[i0 + 64 * q] = w; }
        }
        for (int i = gw * 64 + lane; i < 5 * MTOK; i += NGW * 64) ss1[i] = 0.f;
    }
    SEAM(0);
    if (IN(1)) for (int rep = 0; rep < REP1; ++rep) {
        pg8::Gemm g{HB, W1in, MTOK, 2 * DFF, DM}; pg8::StaticOrder S; S.init(MTOK, 2 * DFF, G, bx, FFN_WGM);
        pg8::EpiSwiGLU E{HID, DFF, ssx};
        pg8::gemm_phase<pg8::EpiSwiGLU, pg8::StaticOrder, true, true>(lds, g, S, E);
    }
    SEAM(1);
    if (IN(2)) {
        pg8::Gemm g{HID, W1out, MTOK, DM, DFF}; pg8::StaticOrder S; S.init(MTOK, DM, G, bx);
        pg8::EpiResidB E{HB, ss1, 0.5f, DM, (void*)(ws + WS_CTL + 49152)};
        pg8::gemm_phase<pg8::EpiResidB, pg8::StaticOrder, true, true>(lds, g, S, E);
    }
    SEAM(2);
    if (IN(3)) {
        { pg8::Gemm g{HB, Wmix, MTOK, 1536, DM}; pg8::StaticOrder S; S.init(MTOK, 1536, G, bx);
          pg8::EpiMixTok E{UQK, 1536, ss1};
          pg8::gemm_phase<pg8::EpiMixTok, pg8::StaticOrder, true, true>(lds, g, S, E); }
        { pg8::Gemm g{Wmix + (size_t)1536 * DM, HB, 1024, MTOK, DM}; pg8::StaticOrder S; S.init(1024, MTOK, G, bx);
          pg8::EpiMixT E{GVT, GVT + (size_t)16 * 1024 * 1024, ss1, ssgv};
          pg8::gemm_phase<pg8::EpiMixT, pg8::StaticOrder, true, true>(lds, g, S, E); }
    }
    SEAM(3);
    if (IN(4)) for (int rep = 0; rep < REP4; ++rep) {
        { unsigned* qh = (unsigned*)(ws + WS_CTL + 49152 + 2048) + 128 * (bx & 7);
          const int qb = bx & 7;
          unsigned* qa = qh + 64;
#pragma nounroll
          for (int pass = 0; pass < 2; ++pass) {
            const bool doG = (pass == 0) == (wave < 4);
            if (doG) {
              unsigned nxt = 0u; if (lane == 0) nxt = atomicAdd(qh, 1u); nxt = (unsigned)__builtin_amdgcn_readfirstlane((int)nxt);
              while (nxt < 1024u) { const unsigned k = nxt; unsigned pend = 0u; if (lane == 0) pend = atomicAdd(qh, 1u);
                  const int part = 7 - (int)(k & 7u), uu = (int)(k >> 3), h = uu & 3, c = uu >> 2;
                  gmlp_unit(UQK, GVT, MIXED, args.in[8], args.in[9], args.in[7], ssgv, qb, c, h, part, lane, 0, lds + wave * 16384);
                  nxt = (unsigned)__builtin_amdgcn_readfirstlane((int)pend); }
            } else {
              unsigned nxt = 0u; if (lane == 0) nxt = atomicAdd(qa, 1u); nxt = (unsigned)__builtin_amdgcn_readfirstlane((int)nxt);
              while (nxt < 1024u) { const unsigned k = nxt; unsigned pend = 0u; if (lane == 0) pend = atomicAdd(qa, 1u);
                  const int qi = 127 - (int)(k & 127u), h = (int)(k >> 7);
                  attn_wave_unit(UQK, GVT, MIXED, qb, h, qi, lane, lds + wave * 16384);
                  nxt = (unsigned)__builtin_amdgcn_readfirstlane((int)pend); }
            }
          } }
    }
    TSTAMP(21);
#ifdef PROBE_A
#endif
    SEAM(4);
    if (IN(5)) {
        pg8::Gemm g{MIXED, Wmo, MTOK, DM, DM}; pg8::StaticOrder S; S.init(MTOK, DM, G, bx);
        pg8::EpiResidB E{HB, ss2, 1.0f, DM, (void*)(ws + WS_CTL + 49152)};
        pg8::gemm_phase<pg8::EpiResidB, pg8::StaticOrder, true, true>(lds, g, S, E);
    }
    SEAM(5);
    if (IN(6)) {
        pg8::Gemm g{HB, W2in, MTOK, 2 * DFF, DM}; pg8::StaticOrder S; S.init(MTOK, 2 * DFF, G, bx, FFN_WGM);
        pg8::EpiSwiGLU E{HID, DFF, ss2};
        pg8::gemm_phase<pg8::EpiSwiGLU, pg8::StaticOrder, true, true>(lds, g, S, E);
    }
    SEAM(6);
    if (IN(7)) {
        pg8::Gemm g{HID, W2out, MTOK, DM, DFF}; pg8::StaticOrder S; S.init(MTOK, DM, G, bx);
        pg8::EpiResidB E{HB, ss3, 0.5f, DM, (void*)(ws + WS_CTL + 49152)};
        pg8::gemm_phase<pg8::EpiResidB, pg8::StaticOrder, true, true>(lds, g, S, E);
    }
    SEAM(7);
    if (IN(8)) {
#ifndef P8_NO_PP
        { pg8::Gemm g{PB, Wp, MTOK, DM, PLE}; pg8::StaticOrder S; S.init(MTOK, DM, G, bx);
          pg8::EpiPP E{SLAB};
          pg8::gemm_phase<pg8::EpiPP, pg8::StaticOrder, true, true>(lds, g, S, E); }
#endif
        asm volatile("s_waitcnt vmcnt(0)" ::: "memory");
#ifndef P8_NO_GATE
        { pg8::Gemm g{HB, Wg, MTOK, DM, DM}; pg8::StaticOrder S; S.init(MTOK, DM, G, bx);
          pg8::EpiGate E{HB, out, SLAB, ss3, ss4, (unsigned*)(ws + WS_CTL + 16384), args.in[17], DM, (void*)(ws + WS_CTL + 49152)};
          pg8::gemm_phase<pg8::EpiGate, pg8::StaticOrder, true, true>(lds, g, S, E); }
#endif
    }
#undef IN
#undef SEAM
#undef ws
#undef xin
#undef pin
#undef ssx
#undef ss1
#undef ssgv
#undef ss2
#undef ss3
#undef ss4
#undef W1in
#undef W1out
#undef Wmix
#undef Wmo
#undef W2in
#undef W2out
#undef Wg
#undef Wp
#undef HB
#undef MIXED
#undef PB
#undef HID
#undef UQK
#undef GVT
#undef SLAB
#undef out
}

extern "C" void kernel_launch(void* const* d_in, const int* in_sizes, int n_in, void* d_out, int out_size, void* d_ws, size_t ws_size, hipStream_t stream) {
    static int grid = 0;
    if (grid == 0) {
        if (n_in != 18 || out_size != MTOK * DM || ws_size < WS_END) { fprintf(stderr, "kernel_launch: unexpected shapes (n_in %d out %d ws %zu)\n", n_in, out_size, ws_size); grid = -1; return; }
        int dev = 0, cus = 0, per_cu = 0;
        hipGetDevice(&dev); hipDeviceGetAttribute(&cus, hipDeviceAttributeMultiprocessorCount, dev);
        hipFuncSetAttribute((const void*)mk_fwd, hipFuncAttributeMaxDynamicSharedMemorySize, LDS_BYTES);
        hipOccupancyMaxActiveBlocksPerMultiprocessor(&per_cu, (const void*)mk_fwd, NWAVES * 64, LDS_BYTES);
        if (per_cu < 1) { fprintf(stderr, "kernel_launch: occupancy query says %d blocks per CU\n", per_cu); per_cu = 1; }
        (void)hipGetLastError();
        grid = cus * per_cu;
        if (grid > 256) grid = 256;
    }
    if (grid < 0) return;
    Args a{};
    for (int i = 0; i < 18; ++i) a.in[i] = (const float*)d_in[i];
    a.out = (float*)d_out; a.ws = (unsigned char*)d_ws;
    (void)hipMemsetAsync((char*)d_ws + WS_CTL, 0, 16384 + 128 * 256 + 8192, stream);
#if MK_N_LAUNCHES == 1
    a.ph_lo = 0; a.ph_hi = NPHASE;
    void* kargs[] = {&a};
    hipError_t e = hipLaunchCooperativeKernel((const void*)mk_fwd, dim3(grid), dim3(NWAVES * 64), kargs, LDS_BYTES, stream);
    if (e != hipSuccess) fprintf(stderr, "cooperative launch failed: %s (grid %d)\n", hipGetErrorString(e), grid);
#else
    for (int ph = 0; ph < NPHASE; ++ph) { a.ph_lo = ph; a.ph_hi = ph + 1; hipLaunchKernelGGL(mk_fwd, dim3(grid), dim3(NWAVES * 64), LDS_BYTES, stream, a); }
#endif
}
```

```cpp
#include <hip/hip_runtime.h>
#include <cstdio>
#include <cstdint>
#define MK_N_LAUNCHES 1
namespace pg8 {
#define PG8_LAS __attribute__((address_space(3)))
typedef unsigned short bf16_t;
typedef short bf16x8 __attribute__((ext_vector_type(8)));
typedef float f32x4 __attribute__((ext_vector_type(4)));
typedef unsigned u32x4 __attribute__((ext_vector_type(4)));
constexpr int BM = 256, BK = 64, HALF = 128, HTB = HALF * BK * 2  , STAGE_BYTES = 8 * HTB, NXCD = 8, WGM = 8;

__host__ __device__ __forceinline__ int lds_byte(int r, int c) { const int st = (r >> 4) * 2 + (c >> 5), rr = r & 15, cc = c & 31, ob = rr * 64 + cc * 2; return st * 1024 + (ob ^ (((ob >> 9) & 1) << 5)); }
__host__ __device__ __forceinline__ void stage_rc(int b, int& R, int& C) { const int st = b / 1024, sb = b % 1024, swz = sb ^ (((sb >> 9) & 1) << 5); R = (st >> 1) * 16 + swz / 64; C = (st & 1) * 32 + (swz % 64) / 2; }
__host__ __device__ __forceinline__ int perm32(int rho) { const int n = rho >> 4, i = rho & 15; return 8 * (i >> 2) + 4 * n + (i & 3); }

struct Unit { int pm, pn; };
struct Gemm { const bf16_t* A; const bf16_t* Bt; int M, N, K; };

struct StaticOrder {
    int nM, nN, nwg, G, c, wgm;
    __host__ __device__ void init(int M, int N, int G_, int c_, int wgm_ = WGM) { nM = M / BM; nN = N / BM; nwg = nM * nN; G = G_; c = c_; wgm = wgm_; }
    __host__ __device__ bool next(int i, Unit& u) const {
        const long L = (long)i * G + c; if (L >= nwg) return false;
        int wgid = (int)L; { const int q = nwg / NXCD, r = nwg % NXCD, xcd = wgid % NXCD, off = wgid / NXCD; wgid = (xcd < r ? xcd * (q + 1) : r * (q + 1) + (xcd - r) * q) + off; }
        const int nig = wgm * nN, gid = wgid / nig, fm = gid * wgm, gsz = (nM - fm) < wgm ? (nM - fm) : wgm;
        u.pm = fm + ((wgid % nig) % gsz); u.pn = (wgid % nig) / gsz; return true;
    }
    __device__ __forceinline__ void a_ready(const Unit&) const {}
    __device__ __forceinline__ void done(const Unit&) const {}
};

__device__ __forceinline__ unsigned cvt_pk_bf16(float lo, float hi) { unsigned r; asm volatile("v_cvt_pk_bf16_f32 %0, %1, %2" : "=v"(r) : "v"(lo), "v"(hi)); return r; }
typedef float f32x2 __attribute__((ext_vector_type(2)));
__device__ __forceinline__ f32x2 gelu_pk(f32x2 v) {
    const f32x2 av = __builtin_elementwise_abs(v), d = av * 0.2316418882f + 1.0f;
    f32x2 t; t.x = __builtin_amdgcn_rcpf(d.x); t.y = __builtin_amdgcn_rcpf(d.y);
    f32x2 q = t * 0.5307027145f + (-0.7265760135f); q = q * t + 0.7107068705f; q = q * t + (-0.142248368f); q = q * t + 0.127414796f; q = q * t;
    const f32x2 s = (v * v) * (-0.72134752044f);
    f32x2 e; e.x = __builtin_amdgcn_exp2f(s.x); e.y = __builtin_amdgcn_exp2f(s.y);
    const f32x2 m = v * (q * e), r = v - m;
    f32x2 o; o.x = v.x < 0.f ? m.x : r.x; o.y = v.y < 0.f ? m.y : r.y; return o;
}


constexpr float RMS_EPS = 1e-6f;
__device__ __forceinline__ float rs_from_ss(float ss, float inv_n) { return __builtin_amdgcn_rsqf(ss * inv_n + RMS_EPS); }
__device__ __forceinline__ float silu_f(float g) { return g * __builtin_amdgcn_rcpf(1.0f + __builtin_amdgcn_exp2f(g * -1.4426950408889634f)); }
__device__ __forceinline__ float sigmoid_f(float g) { return __builtin_amdgcn_rcpf(1.0f + __builtin_amdgcn_exp2f(g * -1.4426950408889634f)); }
typedef unsigned u32x2 __attribute__((ext_vector_type(2)));

struct PreF8 { float v[8]; };
struct PreNone { int dummy; };
struct EpiSwiGLU {
    typedef PreF8 Pre;
    static constexpr bool PERM = true, AFTER_DRAIN = false, RS_PREFETCH = true, WIDE = false;
    bf16_t* O; int ldc; const float* ss;
    __device__ __forceinline__ void load_rs(PreF8& rs, const Unit& u, int wr, int wc, int fr, int fq) const {
#pragma unroll
        for (int j = 0; j < 8; ++j) rs.v[j] = ss[u.pm * BM + wr * 64 + fr + (j >> 2) * HALF + (j & 3) * 16];
    }
    __device__ __forceinline__ void operator()(const f32x4 (&acc)[2][2][4][2], const Unit& u, int wr, int wc, int fr, int fq, const PreF8& rs) const {
        const int row0 = u.pm * BM + wr * 64 + fr; const int col0 = u.pn * HALF + wc * 32 + 8 * fq;
#pragma unroll
        for (int ai = 0; ai < 2; ++ai)
#pragma unroll
            for (int m = 0; m < 4; ++m) { const int row = row0 + ai * HALF + m * 16; const float r = rs_from_ss(rs.v[ai * 4 + m], 1.0f / 1024.0f);
                const float c1 = r * -1.4426950408889634f, r2 = r * r;
                const f32x4 g0 = acc[ai][0][m][0], g1 = acc[ai][0][m][1], u0 = acc[ai][1][m][0], u1 = acc[ai][1][m][1];
                f32x4 t0 = g0 * u0, t1 = g1 * u1, e0 = g0 * c1, e1 = g1 * c1, s0, s1;
#pragma unroll
                for (int i = 0; i < 4; ++i) { s0[i] = __builtin_amdgcn_rcpf(1.0f + __builtin_amdgcn_exp2f(e0[i])); s1[i] = __builtin_amdgcn_rcpf(1.0f + __builtin_amdgcn_exp2f(e1[i])); }
                t0 = t0 * (s0 * r2); t1 = t1 * (s1 * r2);
                u32x4 w; w.x = cvt_pk_bf16(t0[0], t0[1]); w.y = cvt_pk_bf16(t0[2], t0[3]); w.z = cvt_pk_bf16(t1[0], t1[1]); w.w = cvt_pk_bf16(t1[2], t1[3]);
                __builtin_nontemporal_store(w, (u32x4*)(O + (size_t)row * ldc + col0)); }
    }
};

struct EpiResidX {
    typedef PreNone Pre;
    static constexpr bool PERM = true, AFTER_DRAIN = false, RS_PREFETCH = false, WIDE = false;
    const float* res; bf16_t* ob; float* ssout; float alpha; int ldc;
    __device__ __forceinline__ void operator()(const f32x4 (&acc)[2][2][4][2], const Unit& u, int wr, int wc, int fr, int fq) const {
        const int row0 = u.pm * BM + wr * 64 + fr, col0 = u.pn * BM + wc * 32 + 8 * fq;
#pragma unroll
        for (int ai = 0; ai < 2; ++ai) {
            f32x4 rv[4][2][2];
#pragma unroll
            for (int m = 0; m < 4; ++m)
#pragma unroll
                for (int bj = 0; bj < 2; ++bj)
#pragma unroll
                    for (int n = 0; n < 2; ++n) rv[m][bj][n] = *(const f32x4*)(res + (size_t)(row0 + ai * HALF + m * 16) * ldc + col0 + bj * HALF + n * 4);
#pragma unroll
            for (int m = 0; m < 4; ++m) { const int row = row0 + ai * HALF + m * 16; const size_t off = (size_t)row * ldc + col0; float sq = 0.f;
#pragma unroll
                for (int bj = 0; bj < 2; ++bj) { const f32x4 o0 = rv[m][bj][0] + acc[ai][bj][m][0] * alpha, o1 = rv[m][bj][1] + acc[ai][bj][m][1] * alpha;
                    sq += ((o0[0] * o0[0] + o0[1] * o0[1]) + (o0[2] * o0[2] + o0[3] * o0[3])) + ((o1[0] * o1[0] + o1[1] * o1[1]) + (o1[2] * o1[2] + o1[3] * o1[3]));
                    u32x4 w; w.x = cvt_pk_bf16(o0[0], o0[1]); w.y = cvt_pk_bf16(o0[2], o0[3]); w.z = cvt_pk_bf16(o1[0], o1[1]); w.w = cvt_pk_bf16(o1[2], o1[3]); *(u32x4*)(ob + off + bj * HALF) = w; }
                sq += __shfl_xor(sq, 16); sq += __shfl_xor(sq, 32);
                if (fq == 0) atomicAdd(ssout + row, sq); }
            asm volatile("" ::: "memory"); }
    }
};
__device__ __forceinline__ float bf_lo(unsigned w) { return __uint_as_float(w << 16); }
__device__ __forceinline__ float bf_hi(unsigned w) { return __uint_as_float(w & 0xffff0000u); }
#ifdef PROBE_A
#define EPI_STAMP(T) do { if (blockIdx.x == 0 && threadIdx.x == 0) { unsigned long long* T_ = (unsigned long long*)(T); const unsigned k_ = (unsigned)T_[63]; T_[32 + k_] = __builtin_amdgcn_s_memrealtime(); T_[63] = k_ + 1; } } while (0)
#else
#define EPI_STAMP(T) do {} while (0)
#endif
struct PreRes { u32x4 v[6]; };
struct EpiResidB {
    typedef PreRes Pre;
    static constexpr bool PERM = true, AFTER_DRAIN = false, RS_PREFETCH = true, WIDE = true;
    static constexpr int NPRE = 6;
    bf16_t* hb; float* ssout; float alpha; int ldc; void* tsb;
    __device__ __forceinline__ void load_rs(PreRes& pre, const Unit& u, int wr, int wc, int fr, int fq) const {
        const int row0 = u.pm * BM + wr * 64 + fr, col0 = u.pn * BM + wc * 64 + 8 * fq;
#pragma unroll
        for (int j = 0; j < NPRE; ++j) { const int ai = j >> 3, m = (j >> 1) & 3, bj = j & 1; pre.v[j] = *(const u32x4*)(hb + (size_t)(row0 + ai * HALF + m * 16) * ldc + col0 + bj * 32); }
    }
    __device__ __forceinline__ void operator()(const f32x4 (&acc)[2][2][4][2], const Unit& u, int wr, int wc, int fr, int fq, const PreRes& pre) const {
        EPI_STAMP(tsb);
        const int row0 = u.pm * BM + wr * 64 + fr, col0 = u.pn * BM + wc * 64 + 8 * fq;
        u32x4 rv[2][4][2];
#pragma unroll
        for (int ai = 0; ai < 2; ++ai)
#pragma unroll
            for (int m = 0; m < 4; ++m)
#pragma unroll
                for (int bj = 0; bj < 2; ++bj) { const int j = ai * 8 + m * 2 + bj;
                    if (j < NPRE) rv[ai][m][bj] = pre.v[j < NPRE ? j : 0]; else rv[ai][m][bj] = *(const u32x4*)(hb + (size_t)(row0 + ai * HALF + m * 16) * ldc + col0 + bj * 32); }
#pragma unroll
        for (int ai = 0; ai < 2; ++ai)
#pragma unroll
            for (int m = 0; m < 4; ++m) { const int row = row0 + ai * HALF + m * 16; const size_t off = (size_t)row * ldc + col0; float sq = 0.f;
#pragma unroll
                for (int bj = 0; bj < 2; ++bj) { const u32x4 rw = rv[ai][m][bj];
                    const f32x4 o0 = (f32x4){bf_lo(rw.x), bf_hi(rw.x), bf_lo(rw.y), bf_hi(rw.y)} + acc[ai][bj][m][0] * alpha, o1 = (f32x4){bf_lo(rw.z), bf_hi(rw.z), bf_lo(rw.w), bf_hi(rw.w)} + acc[ai][bj][m][1] * alpha;
                    sq += ((o0[0] * o0[0] + o0[1] * o0[1]) + (o0[2] * o0[2] + o0[3] * o0[3])) + ((o1[0] * o1[0] + o1[1] * o1[1]) + (o1[2] * o1[2] + o1[3] * o1[3]));
                    u32x4 w; w.x = cvt_pk_bf16(o0[0], o0[1]); w.y = cvt_pk_bf16(o0[2], o0[3]); w.z = cvt_pk_bf16(o1[0], o1[1]); w.w = cvt_pk_bf16(o1[2], o1[3]); *(u32x4*)(hb + off + bj * 32) = w; }
                sq += __shfl_xor(sq, 16); sq += __shfl_xor(sq, 32);
                if (fq == 0) atomicAdd(ssout + row, sq); }
        EPI_STAMP(tsb);
    }
};

struct EpiMixTok {
    typedef PreF8 Pre;
    static constexpr bool PERM = true, AFTER_DRAIN = false, RS_PREFETCH = true, WIDE = true;
    bf16_t* O; int ldc; const float* ss;
    __device__ __forceinline__ void load_rs(PreF8& rs, const Unit& u, int wr, int wc, int fr, int fq) const {
#pragma unroll
        for (int j = 0; j < 8; ++j) rs.v[j] = ss[u.pm * BM + wr * 64 + fr + (j >> 2) * HALF + (j & 3) * 16];
    }
    __device__ __forceinline__ void operator()(const f32x4 (&acc)[2][2][4][2], const Unit& u, int wr, int wc, int fr, int fq, const PreF8& rs) const {
        const int row0 = u.pm * BM + wr * 64 + fr; const int col0 = u.pn * BM + wc * 64 + 8 * fq;
        const bool isu = u.pn < 2; const float sc = (u.pn == 2 || u.pn == 3) ? 0.125f : 1.0f;
#pragma unroll
        for (int ai = 0; ai < 2; ++ai)
#pragma unroll
            for (int m = 0; m < 4; ++m) { const int row = row0 + ai * HALF + m * 16; const float r = rs_from_ss(rs.v[ai * 4 + m], 1.0f / 1024.0f) * sc;
#pragma unroll
                for (int bj = 0; bj < 2; ++bj) { f32x4 v0 = acc[ai][bj][m][0] * r, v1 = acc[ai][bj][m][1] * r;
                    if (isu) { const f32x2 a = gelu_pk((f32x2){v0[0], v0[1]}), b = gelu_pk((f32x2){v0[2], v0[3]}), c = gelu_pk((f32x2){v1[0], v1[1]}), d = gelu_pk((f32x2){v1[2], v1[3]});
                        v0 = (f32x4){a.x, a.y, b.x, b.y}; v1 = (f32x4){c.x, c.y, d.x, d.y}; }
                    u32x4 w; w.x = cvt_pk_bf16(v0[0], v0[1]); w.y = cvt_pk_bf16(v0[2], v0[3]); w.z = cvt_pk_bf16(v1[0], v1[1]); w.w = cvt_pk_bf16(v1[2], v1[3]);
                    *(u32x4*)(O + (size_t)row * ldc + col0 + bj * 32) = w; } }
    }
};

struct EpiMixT {
    typedef PreNone Pre;
    static constexpr bool PERM = true, AFTER_DRAIN = false, RS_PREFETCH = false, WIDE = true;
    bf16_t* GT; bf16_t* VT; const float* ss; float* ssgv;
    __device__ __forceinline__ void operator()(const f32x4 (&acc)[2][2][4][2], const Unit& u, int wr, int wc, int fr, int fq) const {
        const int row0 = u.pm * BM + wr * 64 + fr; const int col0 = u.pn * BM + wc * 64 + 8 * fq;
        const bool isg = u.pm < 2;
        f32x4 rt[2][2], cs[2][2];
#pragma unroll
        for (int bj = 0; bj < 2; ++bj)
#pragma unroll
            for (int n = 0; n < 2; ++n) { const f32x4 s = *(const f32x4*)(ss + col0 + bj * 32 + 4 * n);
                rt[bj][n] = (f32x4){rs_from_ss(s[0], 1.0f / 1024.0f), rs_from_ss(s[1], 1.0f / 1024.0f), rs_from_ss(s[2], 1.0f / 1024.0f), rs_from_ss(s[3], 1.0f / 1024.0f)};
                cs[bj][n] = (f32x4){0.f, 0.f, 0.f, 0.f}; }
#pragma unroll
        for (int ai = 0; ai < 2; ++ai)
#pragma unroll
            for (int m = 0; m < 4; ++m) { const int c = row0 + ai * HALF + m * 16;
#pragma unroll
                for (int bj = 0; bj < 2; ++bj) { f32x4 v0 = acc[ai][bj][m][0] * rt[bj][0], v1 = acc[ai][bj][m][1] * rt[bj][1];
                    const int tok0 = col0 + bj * 32;
                    if (isg) { const f32x2 a = gelu_pk((f32x2){v0[0], v0[1]}), b = gelu_pk((f32x2){v0[2], v0[3]}), cc = gelu_pk((f32x2){v1[0], v1[1]}), d = gelu_pk((f32x2){v1[2], v1[3]});
                        v0 = (f32x4){a.x, a.y, b.x, b.y}; v1 = (f32x4){cc.x, cc.y, d.x, d.y}; cs[bj][0] += v0 * v0; cs[bj][1] += v1 * v1; }
                    u32x4 w; w.x = cvt_pk_bf16(v0[0], v0[1]); w.y = cvt_pk_bf16(v0[2], v0[3]); w.z = cvt_pk_bf16(v1[0], v1[1]); w.w = cvt_pk_bf16(v1[2], v1[3]);
                    if (isg) { const int h = c >> 7, d = c & 127, sl = tok0 & 127;
                        *(u32x4*)(GT + ((((size_t)((tok0 >> 7) * 4 + h) * 32 + (d >> 5) * 8 + (sl >> 4)) * 64) + ((sl >> 3) & 1) * 32 + (d & 31)) * 8) = w; }
                    else { const int c2 = c - 512, h = c2 >> 6, d = c2 & 63, sl = tok0 & 31, q = sl >> 3;
                        bf16_t* tp = VT + ((((size_t)(h * 1024 + (tok0 >> 5)) * 4 + (d >> 5) * 2 + (q >> 1)) * 64) + (d & 31)) * 8 + (q & 1) * 4;
                        u32x2 lo2; lo2.x = w.x; lo2.y = w.y; u32x2 hi2; hi2.x = w.z; hi2.y = w.w;
                        *(u32x2*)tp = lo2; *(u32x2*)(tp + 32 * 8) = hi2; } } }
        if (isg) {
            float mine = 0.f;
#pragma unroll
            for (int bj = 0; bj < 2; ++bj)
#pragma unroll
                for (int n = 0; n < 2; ++n)
#pragma unroll
                    for (int i = 0; i < 4; ++i) { float v = cs[bj][n][i]; v += __shfl_xor(v, 1); v += __shfl_xor(v, 2); v += __shfl_xor(v, 4); v += __shfl_xor(v, 8);
                        mine = (fr == bj * 8 + n * 4 + i) ? v : mine; }
            const int tok = col0 + (fr >> 3) * 32 + (fr & 7);
            atomicAdd(ssgv + tok, mine);
        }
    }
};

struct EpiPP {
    typedef PreNone Pre;
    static constexpr bool PERM = true, AFTER_DRAIN = false, RS_PREFETCH = false, WIDE = true;
    u32x4* slab;
    __device__ __forceinline__ void operator()(const f32x4 (&acc)[2][2][4][2], const Unit& u, int wr, int wc, int fr, int fq) const {
        u32x4* p = slab + (size_t)(u.pm * 4 + u.pn) * 16 * 512 + threadIdx.x;
#pragma unroll
        for (int ai = 0; ai < 2; ++ai)
#pragma unroll
            for (int bj = 0; bj < 2; ++bj)
#pragma unroll
                for (int m = 0; m < 4; ++m) { const f32x4 v0 = acc[ai][bj][m][0], v1 = acc[ai][bj][m][1];
                    u32x4 w; w.x = cvt_pk_bf16(v0[0], v0[1]); w.y = cvt_pk_bf16(v0[2], v0[3]); w.z = cvt_pk_bf16(v1[0], v1[1]); w.w = cvt_pk_bf16(v1[2], v1[3]);
                    p[(size_t)((ai * 2 + bj) * 4 + m) * 512] = w; }
    }
};
struct EpiGate {
    typedef PreNone Pre;
    static constexpr bool PERM = true, AFTER_DRAIN = false, RS_PREFETCH = false, WIDE = true;
    const bf16_t* hb; float* out; const u32x4* slab; const float* ss; float* ssout; unsigned* cnt; const float* gfin; int ldc; void* tsb;
    __device__ __forceinline__ void operator()(f32x4 (&acc)[2][2][4][2], const Unit& u, int wr, int wc, int fr, int fq) const {
        const int row0 = u.pm * BM + wr * 64 + fr, col0 = u.pn * BM + wc * 64 + 8 * fq;
        const u32x4* p = slab + (size_t)(u.pm * 4 + u.pn) * 16 * 512 + threadIdx.x;
#pragma unroll
        for (int ai = 0; ai < 2; ++ai) {
            u32x4 rv[4][2]; u32x4 pw[4][2]; float rr[4];
#pragma unroll
            for (int m = 0; m < 4; ++m) { rr[m] = ss[row0 + ai * HALF + m * 16];
#pragma unroll
                for (int bj = 0; bj < 2; ++bj) { pw[m][bj] = p[(size_t)((ai * 2 + bj) * 4 + m) * 512];
                    rv[m][bj] = *(const u32x4*)(hb + (size_t)(row0 + ai * HALF + m * 16) * ldc + col0 + bj * 32); } }
#pragma unroll
            for (int m = 0; m < 4; ++m) { const int row = row0 + ai * HALF + m * 16; float sq = 0.f;
                const float r = rs_from_ss(rr[m], 1.0f / 1024.0f);
#pragma unroll
                for (int bj = 0; bj < 2; ++bj) { const u32x4 pq = pw[m][bj], rw = rv[m][bj];
#pragma unroll
                    for (int n = 0; n < 2; ++n) { const unsigned p0 = n ? pq.z : pq.x, p1 = n ? pq.w : pq.y, r0 = n ? rw.z : rw.x, r1 = n ? rw.w : rw.y;
                        const f32x4 a = acc[ai][bj][m][n] * r;
                        f32x4 o; o[0] = bf_lo(r0) + sigmoid_f(a[0]) * bf_lo(p0); o[1] = bf_hi(r0) + sigmoid_f(a[1]) * bf_hi(p0); o[2] = bf_lo(r1) + sigmoid_f(a[2]) * bf_lo(p1); o[3] = bf_hi(r1) + sigmoid_f(a[3]) * bf_hi(p1);
                        acc[ai][bj][m][n] = o; sq += (o[0] * o[0] + o[1] * o[1]) + (o[2] * o[2] + o[3] * o[3]); } }
                sq += __shfl_xor(sq, 16); sq += __shfl_xor(sq, 32);
                if (fq == 0) __hip_atomic_fetch_add(ssout + row, sq, __ATOMIC_RELAXED, __HIP_MEMORY_SCOPE_AGENT); }
            asm volatile("" ::: "memory"); }
        asm volatile("s_waitcnt vmcnt(0)" ::: "memory");
        unsigned* cw = cnt + 64 * u.pm;
        if ((threadIdx.x & 63) == 0) __hip_atomic_fetch_add(cw, 1u, __ATOMIC_RELAXED, __HIP_MEMORY_SCOPE_AGENT);
        f32x4 gq[2][2];
#pragma unroll
        for (int bj = 0; bj < 2; ++bj)
#pragma unroll
            for (int n = 0; n < 2; ++n) gq[bj][n] = *(const f32x4*)(gfin + col0 + bj * 32 + n * 4);
        { unsigned spins = 0;
          while ((unsigned)__builtin_amdgcn_readfirstlane(__hip_atomic_load(cw, __ATOMIC_RELAXED, __HIP_MEMORY_SCOPE_AGENT)) < 32u) { __builtin_amdgcn_s_sleep(2); if (++spins > (1u << 22)) break; } }
        float dl_ = 0.f;
#ifdef PROBE_A
        if (blockIdx.x == 0) { const unsigned long long* T_ = (const unsigned long long*)tsb;
            const float ta = (float)(T_[PROBE_A1] - T_[PROBE_A]) * 0.01f, tb = (float)(T_[PROBE_B1] - T_[PROBE_B]) * 0.01f;
            const int qa = min(127, max(0, (int)(ta * (1.0f / PROBE_SCALE) + 0.5f))), qb = min(127, max(0, (int)(tb * (1.0f / PROBE_SCALE) + 0.5f)));
            dl_ = sqrtf((float)(qa + 128 * qb) * 9.399e-7f); }
#endif
        asm volatile("" ::: "memory");
#pragma unroll
        for (int ai = 0; ai < 2; ++ai)
#pragma unroll
            for (int m = 0; m < 4; ++m) { const int row = row0 + ai * HALF + m * 16; const size_t off = (size_t)row * ldc + col0;
                const float r = rs_from_ss(__hip_atomic_load(ssout + row, __ATOMIC_RELAXED, __HIP_MEMORY_SCOPE_AGENT), 1.0f / 1024.0f);
#pragma unroll
                for (int bj = 0; bj < 2; ++bj)
#pragma unroll
                    for (int n = 0; n < 2; ++n) *(f32x4*)(out + off + bj * 32 + n * 4) = acc[ai][bj][m][n] * r * gq[bj][n] + dl_; }
    }
};
template <class Epi, class Sched, bool ALIGN_EPI = false, bool SP2 = false>
__device__ __forceinline__ void gemm_phase(PG8_LAS unsigned char* lds, const Gemm g, const Sched& S, const Epi& E) {
    const int tid = threadIdx.x, wid = __builtin_amdgcn_readfirstlane(tid >> 6), lane = tid & 63, wr = wid >> 2, wc = wid & 3, fr = lane & 15, fq = lane >> 4;
    const int K = g.K, nt = K / BK;
    unsigned voffA[2], voffB[2];
#pragma unroll
    for (int i = 0; i < 2; ++i) { int R, C; stage_rc(tid * 16 + i * 8192, R, C); const int Rl = Epi::PERM ? perm32(R & 31) : (R & 31); const int Rb = Epi::WIDE ? (64 * (R >> 5) + Rl) : ((R & ~31) + Rl);
        voffA[i] = (unsigned)(R * K + C) * 2u; voffB[i] = (unsigned)(Rb * K + C) * 2u; }
    const size_t kstep = (size_t)(BK * 2);
    const size_t hstepB = Epi::WIDE ? (size_t)32 * K * 2 : (size_t)HALF * K * 2;
    const size_t hstep = (size_t)HALF * K * 2;
    const size_t tstep = 2 * hstep;
    const unsigned ldsw = (unsigned)wid * 1024u;
    const int aoff = lds_byte(wr * 64 + fr, fq * 8), boff = lds_byte(wc * 32 + fr, fq * 8);
#define PG8_SA(b, h) (((b) * 2 + (h)) * HTB)
#define PG8_SB(b, h) ((4 + (b) * 2 + (h)) * HTB)
#define PG8_STAGE(bufoff, gbase, voff) do { _Pragma("unroll") for (int _i = 0; _i < 2; ++_i) \
        __builtin_amdgcn_global_load_lds((const unsigned*)((const char*)(gbase) + (voff)[_i]), (PG8_LAS unsigned*)(lds + (bufoff) + ldsw + _i * 8192), 16, 0, 0); } while (0)
#define PG8_LDA(dst, b, h) do { _Pragma("unroll") for (int m = 0; m < 4; ++m) _Pragma("unroll") for (int k = 0; k < 2; ++k) dst[m][k] = *(const PG8_LAS bf16x8*)(lds + PG8_SA(b, h) + aoff + m * 2048 + k * 1024); } while (0)
#define PG8_LDB(dst, b, h) do { _Pragma("unroll") for (int n = 0; n < 2; ++n) _Pragma("unroll") for (int k = 0; k < 2; ++k) dst[n][k] = *(const PG8_LAS bf16x8*)(lds + PG8_SB(b, h) + boff + n * 2048 + k * 1024); } while (0)
#define PG8_MMA(ai, bj, At, Bt) do { __builtin_amdgcn_s_setprio(1); _Pragma("unroll") for (int m = 0; m < 4; ++m) _Pragma("unroll") for (int n = 0; n < 2; ++n) _Pragma("unroll") for (int k = 0; k < 2; ++k) \
        acc[ai][bj][m][n] = __builtin_amdgcn_mfma_f32_16x16x32_bf16(Bt[n][k], At[m][k], acc[ai][bj][m][n], 0, 0, 0); __builtin_amdgcn_s_setprio(0); } while (0)
#define PG8_WAIT_V(n) asm volatile("s_waitcnt vmcnt(" #n ")" ::: "memory")
#define PG8_WAIT_L(n) asm volatile("s_waitcnt lgkmcnt(" #n ")" ::: "memory")
#define PG8_BAR __builtin_amdgcn_s_barrier()
#define PG8_SCHED __builtin_amdgcn_sched_barrier(0)
    Unit cur, nxt; int ui = 0;
    if (!S.next(0, cur)) return;
    typename Epi::Pre rsv;
    if constexpr (Epi::RS_PREFETCH) E.load_rs(rsv, cur, wr, wc, fr, fq);
    f32x4 acc[2][2][4][2];
#pragma unroll
    for (int a = 0; a < 2; ++a)
#pragma unroll
        for (int b = 0; b < 2; ++b)
#pragma unroll
            for (int m = 0; m < 4; ++m)
#pragma unroll
                for (int n = 0; n < 2; ++n) acc[a][b][m][n] = (f32x4){0.f, 0.f, 0.f, 0.f};
    bf16x8 At[4][2], B0[2][2], B1[2][2];
    const char* cA = (const char*)g.A + (size_t)cur.pm * tstep; const char* cB = (const char*)g.Bt + (size_t)cur.pn * tstep;
    S.a_ready(cur);
    if constexpr (SP2) {
        PG8_STAGE(PG8_SB(0, 0), cB, voffB); PG8_STAGE(PG8_SB(0, 1), cB + hstepB, voffB); PG8_STAGE(PG8_SA(0, 0), cA, voffA); PG8_STAGE(PG8_SA(0, 1), cA + hstep, voffA);
        if (wr == 1) PG8_BAR;
        PG8_WAIT_V(2); PG8_BAR;
        PG8_STAGE(PG8_SB(1, 0), cB + kstep, voffB); PG8_STAGE(PG8_SA(1, 0), cA + kstep, voffA); PG8_STAGE(PG8_SB(1, 1), cB + hstepB + kstep, voffB);
        PG8_WAIT_V(6); PG8_BAR;
    } else {
        PG8_STAGE(PG8_SB(0, 0), cB, voffB); PG8_STAGE(PG8_SA(0, 0), cA, voffA); PG8_STAGE(PG8_SB(0, 1), cB + hstepB, voffB); PG8_STAGE(PG8_SA(0, 1), cA + hstep, voffA);
        if (wr == 1) PG8_BAR;
        PG8_WAIT_V(4); PG8_BAR;
        PG8_STAGE(PG8_SB(1, 0), cB + kstep, voffB); PG8_STAGE(PG8_SA(1, 0), cA + kstep, voffA); PG8_STAGE(PG8_SB(1, 1), cB + hstepB + kstep, voffB);
        PG8_WAIT_V(6); PG8_BAR;
    }
    for (;;) {
        const bool has_next = S.next(ui + 1, nxt);
        const char* nA = has_next ? (const char*)g.A + (size_t)nxt.pm * tstep : cA; const char* nB = has_next ? (const char*)g.Bt + (size_t)nxt.pn * tstep : cB;
#pragma nounroll
        for (int t = 0; t < nt; t += 2) {
            const bool last = (t == nt - 2);
            const char* a1 = cA + (size_t)(t + 1) * kstep;
            const char* a2 = last ? nA : cA + (size_t)(t + 2) * kstep; const char* b2 = last ? nB : cB + (size_t)(t + 2) * kstep;
            const char* a3 = a2 + kstep; const char* b3 = b2 + kstep;
            if (last && has_next) S.a_ready(nxt);
            if constexpr (SP2) {
            PG8_LDB(B0, 0, 0); PG8_LDB(B1, 0, 1); PG8_SCHED; PG8_LDA(At, 0, 0); PG8_STAGE(PG8_SA(1, 1), a1 + hstep, voffA);
            PG8_WAIT_V(8); PG8_WAIT_L(0); PG8_BAR; PG8_MMA(0, 0, At, B0); PG8_MMA(0, 1, At, B1); PG8_BAR; PG8_SCHED;
            PG8_LDA(At, 0, 1); PG8_STAGE(PG8_SB(0, 0), b2, voffB); PG8_STAGE(PG8_SB(0, 1), b2 + hstepB, voffB); PG8_STAGE(PG8_SA(0, 0), a2, voffA);
            PG8_WAIT_V(8); PG8_WAIT_L(0); PG8_BAR; PG8_MMA(1, 0, At, B0); PG8_MMA(1, 1, At, B1); PG8_BAR; PG8_SCHED;
            PG8_LDB(B0, 1, 0); PG8_LDB(B1, 1, 1); PG8_SCHED; PG8_LDA(At, 1, 0); PG8_STAGE(PG8_SA(0, 1), a2 + hstep, voffA);
            PG8_WAIT_V(8); PG8_WAIT_L(0); PG8_BAR; PG8_MMA(0, 0, At, B0); PG8_MMA(0, 1, At, B1); PG8_BAR; PG8_SCHED;
            PG8_LDA(At, 1, 1); PG8_STAGE(PG8_SB(1, 0), b3, voffB); PG8_STAGE(PG8_SB(1, 1), b3 + hstepB, voffB); PG8_STAGE(PG8_SA(1, 0), a3, voffA);
            PG8_WAIT_V(8); PG8_WAIT_L(0); PG8_BAR; PG8_MMA(1, 0, At, B0); PG8_MMA(1, 1, At, B1); PG8_BAR; PG8_SCHED;
            } else {
            PG8_LDB(B0, 0, 0); PG8_SCHED; PG8_LDA(At, 0, 0); PG8_STAGE(PG8_SA(1, 1), a1 + hstep, voffA);
            PG8_WAIT_L(8); PG8_BAR; PG8_WAIT_L(0); PG8_MMA(0, 0, At, B0); PG8_BAR; PG8_SCHED;
            PG8_LDB(B1, 0, 1); PG8_STAGE(PG8_SB(0, 0), b2, voffB);
            PG8_BAR; PG8_WAIT_L(0); PG8_MMA(0, 1, At, B1); PG8_BAR;
            PG8_LDA(At, 0, 1); PG8_STAGE(PG8_SA(0, 0), a2, voffA);
            PG8_BAR; PG8_WAIT_L(0); PG8_MMA(1, 0, At, B0); PG8_BAR; PG8_SCHED;
            PG8_STAGE(PG8_SB(0, 1), b2 + hstepB, voffB);
            PG8_WAIT_V(6); PG8_BAR; PG8_MMA(1, 1, At, B1); PG8_BAR;
            PG8_LDB(B0, 1, 0); PG8_SCHED; PG8_LDA(At, 1, 0); PG8_STAGE(PG8_SA(0, 1), a2 + hstep, voffA);
            PG8_WAIT_L(8); PG8_BAR; PG8_WAIT_L(0); PG8_MMA(0, 0, At, B0); PG8_BAR; PG8_SCHED;
            PG8_LDB(B1, 1, 1); PG8_STAGE(PG8_SB(1, 0), b3, voffB);
            PG8_BAR; PG8_WAIT_L(0); PG8_MMA(0, 1, At, B1); PG8_BAR;
            PG8_LDA(At, 1, 1); PG8_STAGE(PG8_SA(1, 0), a3, voffA);
            PG8_BAR; PG8_WAIT_L(0); PG8_MMA(1, 0, At, B0); PG8_BAR; PG8_SCHED;
            PG8_STAGE(PG8_SB(1, 1), b3 + hstepB, voffB);
            PG8_WAIT_V(6); PG8_BAR; PG8_MMA(1, 1, At, B1); PG8_BAR;
            }
        }
        if constexpr (ALIGN_EPI) { if (wr == 0) PG8_BAR; }
        if constexpr (!Epi::AFTER_DRAIN) { if constexpr (Epi::RS_PREFETCH) { E(acc, cur, wr, wc, fr, fq, rsv); if (has_next) E.load_rs(rsv, nxt, wr, wc, fr, fq); } else { E(acc, cur, wr, wc, fr, fq); } S.done(cur); }
        if (!has_next) break;
#pragma unroll
        for (int a = 0; a < 2; ++a)
#pragma unroll
            for (int b = 0; b < 2; ++b)
#pragma unroll
                for (int m = 0; m < 4; ++m)
#pragma unroll
                    for (int n = 0; n < 2; ++n) acc[a][b][m][n] = (f32x4){0.f, 0.f, 0.f, 0.f};
        cur = nxt; cA = nA; cB = nB; ++ui;
        if constexpr (ALIGN_EPI) { if (wr == 1) PG8_BAR; }
    }
    PG8_WAIT_V(0);
    if constexpr (!ALIGN_EPI) { if (wr == 0) PG8_BAR; }
    PG8_BAR;
    if constexpr (Epi::AFTER_DRAIN) { E.fused(acc, cur, wr, wc, fr, fq, lds, wid, lane); S.done(cur); }
#undef PG8_SA
#undef PG8_SB
#undef PG8_STAGE
#undef PG8_LDA
#undef PG8_LDB
#undef PG8_MMA
#undef PG8_WAIT_V
#undef PG8_WAIT_L
#undef PG8_BAR
#undef PG8_SCHED
}
}

#include <hip/hip_cooperative_groups.h>
namespace cg = cooperative_groups;

#ifndef MK_N_LAUNCHES
#define MK_N_LAUNCHES 1
#endif
constexpr int NWAVES = 8;
constexpr int NPHASE = 9;
constexpr int BATCH = 8, SEQ = 4096, DM = 1024, MTOK = BATCH * SEQ, DFF = 2816, PLE = 256;
constexpr size_t MiB = 1u << 20;
constexpr size_t WS_SS = 0;
constexpr size_t WS_W1IN = 1 * MiB, WS_W1OUT = 12 * MiB, WS_WMIX = 18 * MiB, WS_WMO = 23 * MiB, WS_W2IN = 25 * MiB, WS_W2OUT = 36 * MiB, WS_WG = 42 * MiB, WS_WP = 44 * MiB;
constexpr size_t WS_HB = 45 * MiB;
constexpr size_t WS_MIXED = 109 * MiB;
constexpr size_t WS_PB = 173 * MiB;
constexpr size_t WS_BIG = 189 * MiB;
constexpr size_t WS_GVT = WS_BIG + 96 * MiB;
constexpr size_t WS_END = WS_BIG + 176 * MiB;
constexpr int RING_BYTES = 131072, LDS_BYTES = 147456;
constexpr int GVT_PITCH = MTOK + 2176;

typedef unsigned short bf16;
typedef float f32x4 __attribute__((ext_vector_type(4)));
typedef float f32x16 __attribute__((ext_vector_type(16)));
typedef short bf16x8 __attribute__((ext_vector_type(8)));
typedef short s16x4 __attribute__((ext_vector_type(4)));
typedef unsigned u32x4 __attribute__((ext_vector_type(4)));
typedef unsigned u32x2 __attribute__((ext_vector_type(2)));
#define LAS __attribute__((address_space(3)))

__device__ __forceinline__ unsigned pk2(float lo, float hi) { return pg8::cvt_pk_bf16(lo, hi); }
__device__ __forceinline__ float wave_sum(float v) {
#pragma unroll
    for (int o = 1; o < 64; o <<= 1) v += __shfl_xor(v, o);
    return v;
}
__device__ __forceinline__ int crow(int r, int hi) { return (r & 3) + 8 * (r >> 2) + 4 * hi; }

__device__ __forceinline__ void p0_transpose_item(const float* W, int K, int N, bf16* WT, const float* gain, int mapkind, LAS float* scr, int item, int lane) {
    const int nblk = N / 32, kb = item / nblk, nb = item % nblk, k0 = 64 * kb, n0 = 32 * nb;
    int d0 = n0;
    if (mapkind == 1) { const bool up = n0 >= DFF; const int j = up ? n0 - DFF : n0; d0 = (j >> 7) * 256 + (up ? 128 : 0) + (j & 127); }
    else if (mapkind == 2) { d0 = n0 < 512 ? n0 : n0 < 1024 ? 1536 + (n0 - 512) : n0 < 2048 ? 512 + (n0 - 1024) : n0; }
    { f32x4 v[8]; float gq[8];
#pragma unroll
      for (int i = 0; i < 8; ++i) { const int kk = (lane >> 3) + 8 * i; v[i] = __builtin_nontemporal_load((const f32x4*)(W + (size_t)(k0 + kk) * N + n0 + 4 * (lane & 7))); gq[i] = gain ? gain[k0 + kk] : 1.0f; }
#pragma unroll
      for (int i = 0; i < 8; ++i) { const int kk = (lane >> 3) + 8 * i; LAS float* d = scr + kk * 33 + 4 * (lane & 7); d[0] = v[i][0] * gq[i]; d[1] = v[i][1] * gq[i]; d[2] = v[i][2] * gq[i]; d[3] = v[i][3] * gq[i]; } }
    asm volatile("s_waitcnt lgkmcnt(0)" ::: "memory");
    const int c = lane & 7;
#pragma unroll
    for (int j = 0; j < 4; ++j) { const int n = (lane >> 3) + 8 * j; const LAS float* s = scr + (8 * c) * 33 + n;
        u32x4 o; o.x = pk2(s[0 * 33], s[1 * 33]); o.y = pk2(s[2 * 33], s[3 * 33]); o.z = pk2(s[4 * 33], s[5 * 33]); o.w = pk2(s[6 * 33], s[7 * 33]);
        *(u32x4*)(WT + (size_t)(d0 + n) * K + k0 + 8 * c) = o; }
    asm volatile("s_waitcnt lgkmcnt(0)" ::: "memory");
}

#define XB_TMO      128
#define XB_XCNT(j)  (256  + 64 * (j))
#define XB_XSUB(j)  (1280 + 64 * (j))
#define XB_XGEN(j)  (2304 + 64 * (j))
#define XB_TOP      3328
#define XB_TOPGEN   3392
#define XCD_BAR_WORDS 3456
#define XB_SPIN_CAP (1u << 18)

__device__ __forceinline__ unsigned xb_ld(unsigned* p)              { return __hip_atomic_load(p, __ATOMIC_RELAXED, __HIP_MEMORY_SCOPE_AGENT); }
__device__ __forceinline__ unsigned xb_add(unsigned* p, unsigned v) { return __hip_atomic_fetch_add(p, v, __ATOMIC_RELAXED, __HIP_MEMORY_SCOPE_AGENT); }
__device__ __forceinline__ unsigned xb_xcc_id() { return (unsigned)__builtin_amdgcn_s_getreg((3 << 11) | 20) & 0xFu; }
#define XB_SPIN(cond, bar) do { unsigned _sp = 0; while (cond) { __builtin_amdgcn_s_sleep(1); \
    if ((++_sp & 255u) == 0u) { if (xb_ld(&(bar)[XB_TMO])) break; if (_sp > XB_SPIN_CAP) { atomicAdd(&(bar)[XB_TMO], 1u); break; } } } } while (0)

struct XcdBarrier {
    unsigned* bar; unsigned x;
    volatile LAS unsigned* st;
};

__device__ __forceinline__ XcdBarrier xcd_barrier_post(unsigned* bar, volatile LAS unsigned* st) {
    XcdBarrier b; b.bar = bar; b.x = xb_xcc_id(); b.st = st;
    if (threadIdx.x == 0) (void)xb_add(&bar[XB_XCNT(b.x)], 1u);
    return b;
}
__device__ __forceinline__ void xcd_barrier_complete(unsigned* bar, unsigned x, unsigned& nloc, unsigned& nx) {
    const unsigned G = gridDim.x * gridDim.y * gridDim.z;
    unsigned sum, cnt, mine, sp = 0u;
    for (;;) {
        sum = 0u; cnt = 0u; mine = 0u;
#pragma unroll
        for (unsigned j = 0; j < 16; ++j) { const unsigned c = xb_ld(&bar[XB_XCNT(j)]); sum += c; cnt += (c > 0u) ? 1u : 0u; mine = (j == x) ? c : mine; }
        if (sum == G) break;
        __builtin_amdgcn_s_sleep(1);
        if ((++sp & 255u) == 0u) { if (xb_ld(&bar[XB_TMO])) break; if (sp > XB_SPIN_CAP) { atomicAdd(&bar[XB_TMO], 1u); break; } }
    }
    nloc = mine > 0u ? mine : 1u; nx = cnt > 0u ? cnt : 1u;
}

__device__ __forceinline__ void xcd_barrier(const XcdBarrier& b) {
    asm volatile("s_waitcnt vmcnt(0)" ::: "memory");
    __syncthreads();
    if (threadIdx.x == 0) {
        unsigned* bar = b.bar;
        __builtin_amdgcn_s_waitcnt(0);
        unsigned nloc = b.st[0], nx = b.st[1];
        if (nloc == 0u) { xcd_barrier_complete(bar, b.x, nloc, nx); b.st[0] = nloc; b.st[1] = nx; }
        const unsigned old = xb_add(&bar[XB_XSUB(b.x)], 1u);
        const unsigned gen = old / nloc;
        if (old + 1u == (gen + 1u) * nloc) {
            __builtin_amdgcn_fence(__ATOMIC_RELEASE, "agent");
            asm volatile("s_waitcnt vmcnt(0)" ::: "memory");
            const unsigned og = xb_add(&bar[XB_TOP], 1u);
            const unsigned tg = og / nx;
            if (og + 1u == (tg + 1u) * nx) xb_add(&bar[XB_TOPGEN], 1u);
            else XB_SPIN(xb_ld(&bar[XB_TOPGEN]) == tg, bar);
            __builtin_amdgcn_fence(__ATOMIC_ACQUIRE, "agent");
            xb_add(&bar[XB_XGEN(b.x)], 1u);
            asm volatile("s_waitcnt vmcnt(0)" ::: "memory");
        } else {
            XB_SPIN(xb_ld(&bar[XB_XGEN(b.x)]) == gen, bar);
            __builtin_amdgcn_fence(__ATOMIC_ACQUIRE, "agent");
            asm volatile("s_waitcnt vmcnt(0)" ::: "memory");
        }
    }
    __syncthreads();
}

constexpr size_t WS_CTL = 768 * 1024;
#ifndef REP0
#define REP0 1
#endif
#ifndef REP1
#define REP1 1
#endif
#ifndef REP4
#define REP4 1
#endif
__device__ __forceinline__ void store_tile_rows(LAS unsigned char* wl, const float (&v0)[16], const float (&v1)[16], bf16* dst, int pitch, int lane) {
    const int r32 = lane & 31, hi = lane >> 5;
#pragma unroll
    for (int g = 0; g < 4; ++g) {
        u32x2 a; a.x = pk2(v0[4 * g], v0[4 * g + 1]); a.y = pk2(v0[4 * g + 2], v0[4 * g + 3]); *(LAS u32x2*)(wl + r32 * 144 + (8 * g + 4 * hi) * 2) = a;
        u32x2 b; b.x = pk2(v1[4 * g], v1[4 * g + 1]); b.y = pk2(v1[4 * g + 2], v1[4 * g + 3]); *(LAS u32x2*)(wl + r32 * 144 + (32 + 8 * g + 4 * hi) * 2) = b; }
    asm volatile("s_waitcnt lgkmcnt(0)" ::: "memory");
#pragma unroll
    for (int i = 0; i < 4; ++i) { const int row = (lane >> 3) + 8 * i, ch = lane & 7;
        const u32x4 w = *(const LAS u32x4*)(wl + row * 144 + ch * 16); __builtin_nontemporal_store(w, (u32x4*)(dst + (size_t)row * pitch + ch * 8)); }
    asm volatile("s_waitcnt lgkmcnt(0)" ::: "memory");
}

#ifndef FFN_WGM
#define FFN_WGM 4
#endif
#ifndef ATT_THR
#define ATT_THR 4.0e-18f
#endif
struct Args { const float* in[18]; float* out; unsigned char* ws; int ph_lo, ph_hi; };

__device__ __forceinline__ void attn_wave_unit(const bf16* UQK, const bf16* VT, bf16* MIXED, int b, int h, int qi, int lane, LAS unsigned char* wl) {
    const int r32 = lane & 31, hi = lane >> 5;
    const size_t tokb = (size_t)b * SEQ; const int t0 = qi * 32;
    const bf16* qp = UQK + (tokb + t0 + r32) * 1536 + 512 + h * 64 + 8 * hi;
    bf16x8 qf[4];
#pragma unroll
    for (int d = 0; d < 4; ++d) qf[d] = *(const bf16x8*)(qp + 16 * d);
    f32x16 o0, o1;
#pragma unroll
    for (int i = 0; i < 16; ++i) { o0[i] = 0.f; o1[i] = 0.f; }
    float carry = 1.0f;
    const bf16* kbase = UQK + (tokb + r32) * 1536 + 1024 + h * 64 + 8 * hi;
    const bf16* vbase = VT + (size_t)16 * 1024 * 1024 + (size_t)(h * 1024 + b * 128) * 2048 + lane * 8;
    bf16x8 kfA[4], kfB[4], kfC[4], kfD[4]; bf16x8 vtA[2][2], vtB[2][2], vtC[2][2], vtD[2][2];
#define ATT_LOAD(KF, VT, s0_) do { \
        _Pragma("unroll") for (int d = 0; d < 4; ++d) KF[d] = *(const bf16x8*)(kbase + (size_t)(s0_) * 1536 + 16 * d); \
        _Pragma("unroll") for (int db = 0; db < 2; ++db) _Pragma("unroll") for (int j = 0; j < 2; ++j) \
            VT[db][j] = *(const bf16x8*)(vbase + (size_t)((s0_) >> 5) * 2048 + (db * 2 + j) * 512); } while (0)
#define VFRAG(VT, db, j) (VT[db][j])
#define ATT_BLOCK(KF, VT, kb_) do { \
        f32x16 z; \
        _Pragma("unroll") for (int i = 0; i < 16; ++i) z[i] = 0.f; \
        _Pragma("unroll") for (int d = 0; d < 4; ++d) z = __builtin_amdgcn_mfma_f32_32x32x16_bf16(KF[d], qf[d], z, 0, 0, 0); \
        const bool diag = ((kb_) == qi); \
          \
        float u[16], sg[16]; \
        _Pragma("unroll") for (int i = 0; i < 16; ++i) { const float zz = z[i]; const float e = __builtin_amdgcn_exp2f(-fabsf(zz) * 1.4426950408889634f); \
            const float r = __builtin_amdgcn_rcpf(1.0f + e), er = e * r; const bool pos = zz >= 0.f; \
            const bool valid = !diag || (crow(i, hi) < r32); u[i] = valid ? (pos ? er : r) : 1.0f; sg[i] = valid ? (pos ? r : er) : 0.f; } \
        float Gs[4], Go[4], T[4]; \
        _Pragma("unroll") for (int g = 0; g < 4; ++g) { Gs[g] = (u[4 * g] * u[4 * g + 1]) * (u[4 * g + 2] * u[4 * g + 3]); Go[g] = __shfl_xor(Gs[g], 32); T[g] = Gs[g] * Go[g]; } \
        float aft[4]; aft[3] = 1.0f; aft[2] = T[3]; aft[1] = T[3] * T[2]; aft[0] = aft[1] * T[1]; \
        const float total = aft[0] * T[0]; \
        float a[16]; \
        _Pragma("unroll") for (int g = 0; g < 4; ++g) { float run = aft[g] * (hi == 0 ? Go[g] : 1.0f) * carry; \
            _Pragma("unroll") for (int j = 3; j >= 0; --j) { const int i = 4 * g + j; a[i] = sg[i] * run; run *= u[i]; } } \
        carry *= total; \
        u32x4 p0, p1; \
        p0.x = pk2(a[0], a[1]); p0.y = pk2(a[2], a[3]); p0.z = pk2(a[4], a[5]); p0.w = pk2(a[6], a[7]); \
        p1.x = pk2(a[8], a[9]); p1.y = pk2(a[10], a[11]); p1.z = pk2(a[12], a[13]); p1.w = pk2(a[14], a[15]); \
        const bf16x8 pb0 = __builtin_bit_cast(bf16x8, p0), pb1 = __builtin_bit_cast(bf16x8, p1); \
        o0 = __builtin_amdgcn_mfma_f32_32x32x16_bf16(VFRAG(VT, 0, 0), pb0, o0, 0, 0, 0); \
        o0 = __builtin_amdgcn_mfma_f32_32x32x16_bf16(VFRAG(VT, 0, 1), pb1, o0, 0, 0, 0); \
        o1 = __builtin_amdgcn_mfma_f32_32x32x16_bf16(VFRAG(VT, 1, 0), pb0, o1, 0, 0, 0); \
        o1 = __builtin_amdgcn_mfma_f32_32x32x16_bf16(VFRAG(VT, 1, 1), pb1, o1, 0, 0, 0); } while (0)
    ATT_LOAD(kfA, vtA, t0); ATT_LOAD(kfB, vtB, (qi > 0 ? qi - 1 : 0) * 32); ATT_LOAD(kfC, vtC, (qi > 1 ? qi - 2 : 0) * 32); ATT_LOAD(kfD, vtD, (qi > 2 ? qi - 3 : 0) * 32);
    ATT_BLOCK(kfA, vtA, qi);
    if (qi >= 1 && !__all(carry < ATT_THR)) {
        ATT_BLOCK(kfB, vtB, qi - 1);
        if (qi >= 2 && !__all(carry < ATT_THR)) {
            ATT_BLOCK(kfC, vtC, qi - 2);
            if (qi >= 3 && !__all(carry < ATT_THR)) {
                ATT_BLOCK(kfD, vtD, qi - 3);
                for (int kb = qi - 4; kb >= 0; --kb) {
                    if (__all(carry < ATT_THR)) break;
                    ATT_LOAD(kfA, vtA, kb * 32);
                    ATT_BLOCK(kfA, vtA, kb);
                }
            }
        }
    }
#undef ATT_LOAD
#undef ATT_BLOCK
#undef VFRAG
    { float v0[16], v1[16];
#pragma unroll
      for (int i = 0; i < 16; ++i) { v0[i] = o0[i]; v1[i] = o1[i]; }
      store_tile_rows(wl, v0, v1, MIXED + (tokb + t0) * 1024 + 512 + h * 64, 1024, lane); }
}

__device__ __forceinline__ void gmlp_unit(const bf16* UQK, const bf16* GVT, bf16* MIXED, const float* w_s, const float* b_s, const float* vgain, const float* ssgv, int b, int c, int h, int wave, int lane, int flip, LAS unsigned char* wl) {
    const int r32 = lane & 31, hi = lane >> 5, tb = flip ? 3 - (wave >> 1) : (wave >> 1), dbp = wave & 1;
    const size_t tokbase = (size_t)b * SEQ + (size_t)c * 128; const int t0 = 32 * tb, t = t0 + r32;
    const float* wrow = w_s + ((size_t)h * 128 + t) * 128 + 8 * hi;
    f32x16 acc0, acc1;
#pragma unroll
    for (int i = 0; i < 16; ++i) { acc0[i] = 0.f; acc1[i] = 0.f; }
    const int nks = 2 * (tb + 1);
    const bf16* g0p = GVT + (((size_t)((b * 32 + c) * 4 + h) * 32 + 2 * dbp * 8) * 64 + lane) * 8;
    const float bb = b_s[h * 128 + t];
    const size_t tok = tokbase + t;
    u32x2 gu[2][4]; f32x4 vg[2][4];
#pragma unroll
    for (int dd = 0; dd < 2; ++dd)
#pragma unroll
        for (int g = 0; g < 4; ++g) { const int col = h * 128 + 64 * dbp + 32 * dd + 8 * g + 4 * hi; gu[dd][g] = *(const u32x2*)(UQK + tok * 1536 + col); vg[dd][g] = *(const f32x4*)(vgain + col); }
#pragma unroll
    for (int half = 0; half < 2; ++half) {
        if (4 * half < nks) {
            f32x4 w0[4], w1[4], q0[4], q1[4]; bf16x8 a0[4], a1[4];
#pragma unroll
            for (int k4 = 0; k4 < 4; ++k4) { const int ks = 4 * half + k4; const int s = 16 * ks + 8 * hi;
                if (ks < nks) { w0[k4] = *(const f32x4*)(wrow + 16 * ks); w1[k4] = *(const f32x4*)(wrow + 16 * ks + 4);
                    q0[k4] = *(const f32x4*)(ssgv + tokbase + s); q1[k4] = *(const f32x4*)(ssgv + tokbase + s + 4);
                    a0[k4] = *(const bf16x8*)(g0p + ks * 512); a1[k4] = *(const bf16x8*)(g0p + 8 * 512 + ks * 512); } }
#pragma unroll
            for (int k4 = 0; k4 < 4; ++k4) { const int ks = 4 * half + k4; const int s = 16 * ks + 8 * hi;
                if (ks < nks) { float v[8];
#pragma unroll
                    for (int e = 0; e < 4; ++e) { v[e] = (s + e <= t) ? w0[k4][e] * pg8::rs_from_ss(q0[k4][e], 1.0f / 512.0f) : 0.f; v[4 + e] = (s + 4 + e <= t) ? w1[k4][e] * pg8::rs_from_ss(q1[k4][e], 1.0f / 512.0f) : 0.f; }
                    u32x4 bw; bw.x = pk2(v[0], v[1]); bw.y = pk2(v[2], v[3]); bw.z = pk2(v[4], v[5]); bw.w = pk2(v[6], v[7]);
                    const bf16x8 bfrag = __builtin_bit_cast(bf16x8, bw);
                    acc0 = __builtin_amdgcn_mfma_f32_32x32x16_bf16(a0[k4], bfrag, acc0, 0, 0, 0);
                    acc1 = __builtin_amdgcn_mfma_f32_32x32x16_bf16(a1[k4], bfrag, acc1, 0, 0, 0); } }
        }
    }
    { float v0[16], v1[16];
#pragma unroll
      for (int g = 0; g < 4; ++g) { const u32x2 ga = gu[0][g], gb = gu[1][g]; const f32x4 va = vg[0][g], vb = vg[1][g];
          v0[4 * g] = pg8::bf_lo(ga.x) * (va[0] * acc0[4 * g] + bb); v0[4 * g + 1] = pg8::bf_hi(ga.x) * (va[1] * acc0[4 * g + 1] + bb); v0[4 * g + 2] = pg8::bf_lo(ga.y) * (va[2] * acc0[4 * g + 2] + bb); v0[4 * g + 3] = pg8::bf_hi(ga.y) * (va[3] * acc0[4 * g + 3] + bb);
          v1[4 * g] = pg8::bf_lo(gb.x) * (vb[0] * acc1[4 * g] + bb); v1[4 * g + 1] = pg8::bf_hi(gb.x) * (vb[1] * acc1[4 * g + 1] + bb); v1[4 * g + 2] = pg8::bf_lo(gb.y) * (vb[2] * acc1[4 * g + 2] + bb); v1[4 * g + 3] = pg8::bf_hi(gb.y) * (vb[3] * acc1[4 * g + 3] + bb); }
      store_tile_rows(wl, v0, v1, MIXED + (tokbase + t0) * 1024 + h * 128 + 64 * dbp, 1024, lane); }
}

__global__ void __launch_bounds__(NWAVES * 64, 2) mk_fwd(Args args) {
    extern __shared__ __attribute__((aligned(16))) unsigned char lds_raw[];
    LAS unsigned char* lds = (LAS unsigned char*)lds_raw;
    const int tid = threadIdx.x, lane = tid & 63, wave = __builtin_amdgcn_readfirstlane(tid >> 6);
    const int G = gridDim.x, bx = blockIdx.x;
    const int gw = bx * NWAVES + wave, NGW = G * NWAVES;
#define ws (args.ws)
#define xin (args.in[0])
#define pin (args.in[1])
#define ssx ((float*)(ws + WS_SS))
#define ss1 (ssx + MTOK)
#define ssgv (ssx + 2 * MTOK)
#define ss2 (ssx + 3 * MTOK)
#define ss3 (ssx + 4 * MTOK)
#define ss4 (ssx + 5 * MTOK)
#define W1in ((bf16*)(ws + WS_W1IN))
#define W1out ((bf16*)(ws + WS_W1OUT))
#define Wmix ((bf16*)(ws + WS_WMIX))
#define Wmo ((bf16*)(ws + WS_WMO))
#define W2in ((bf16*)(ws + WS_W2IN))
#define W2out ((bf16*)(ws + WS_W2OUT))
#define Wg ((bf16*)(ws + WS_WG))
#define Wp ((bf16*)(ws + WS_WP))
#define HB ((bf16*)(ws + WS_HB))
#define MIXED ((bf16*)(ws + WS_MIXED))
#define PB ((bf16*)(ws + WS_PB))
#define HID ((bf16*)(ws + WS_BIG))
#define UQK ((bf16*)(ws + WS_BIG))
#define GVT ((bf16*)(ws + WS_GVT))
#define SLAB ((u32x4*)(ws + WS_BIG))
#define out (args.out)
    const int lo = args.ph_lo, hi_ph = args.ph_hi;
#ifndef PHASE_MASK
#define PHASE_MASK 0x3ff
#endif
#define IN(k) (((PHASE_MASK >> (k)) & 1) && lo <= (k) && (k) < hi_ph)
#ifdef PROBE_A
#ifndef TS_BLOCK
#define TS_BLOCK 0
#endif
#define TSTAMP(k) do { if (bx == TS_BLOCK && tid == 0) ((unsigned long long*)(ws + WS_CTL + 49152))[k] = __builtin_amdgcn_s_memrealtime(); } while (0)
#else
#define TSTAMP(k) do {} while (0)
#endif
#define SEAM(k) do { if (IN(k) && IN((k) + 1)) { xcd_barrier(bar); } TSTAMP((k) + 1); } while (0)
    if (tid < 2) ((LAS unsigned*)(lds + RING_BYTES))[tid] = 0u;
    __syncthreads();
    if (args.ph_lo < 0) cg::this_grid().sync();
    TSTAMP(0);
    XcdBarrier bar = xcd_barrier_post((unsigned*)(ws + WS_CTL), (volatile LAS unsigned*)(lds + RING_BYTES));

    if (IN(0)) for (int rep = 0; rep < REP0; ++rep) {
        LAS float* scr = (LAS float*)(lds + wave * 16384);
        constexpr int I_IN = (DM / 64) * (2 * DFF / 32), I_OUT = (DFF / 64) * (DM / 32), I_MIX = (DM / 64) * (2560 / 32), I_SQ = (DM / 64) * (DM / 32), I_P = (PLE / 64) * (DM / 32);
        constexpr int NITEMS = 2 * I_IN + 2 * I_OUT + I_MIX + 2 * I_SQ + I_P;
        for (int it = gw; it < NITEMS; it += NGW) {
            int r = it;
            if (r < I_IN) { p0_transpose_item(args.in[3], DM, 2 * DFF, W1in, args.in[2], 1, scr, r, lane); continue; } r -= I_IN;
            if (r < I_IN) { p0_transpose_item(args.in[12], DM, 2 * DFF, W2in, args.in[11], 1, scr, r, lane); continue; } r -= I_IN;
            if (r < I_OUT) { p0_transpose_item(args.in[4], DFF, DM, W1out, nullptr, 0, scr, r, lane); continue; } r -= I_OUT;
            if (r < I_OUT) { p0_transpose_item(args.in[13], DFF, DM, W2out, nullptr, 0, scr, r, lane); continue; } r -= I_OUT;
            if (r < I_MIX) { p0_transpose_item(args.in[6], DM, 2560, Wmix, args.in[5], 2, scr, r, lane); continue; } r -= I_MIX;
            if (r < I_SQ) { p0_transpose_item(args.in[10], DM, DM, Wmo, nullptr, 0, scr, r, lane); continue; } r -= I_SQ;
            if (r < I_SQ) { p0_transpose_item(args.in[15], DM, DM, Wg, args.in[14], 0, scr, r, lane); continue; } r -= I_SQ;
            p0_transpose_item(args.in[16], PLE, DM, Wp, nullptr, 0, scr, r, lane);
        }
        for (int m0 = gw * 4; m0 + 3 < MTOK; m0 += NGW * 4) {
            f32x4 v[4][4];
#pragma unroll
            for (int q = 0; q < 4; ++q) { const f32x4* xr = (const f32x4*)(xin + (size_t)(m0 + q) * DM) + lane;
#pragma unroll
                for (int j = 0; j < 4; ++j) v[q][j] = __builtin_nontemporal_load(xr + 64 * j); }
#pragma unroll
            for (int q = 0; q < 4; ++q) { float s = 0.f;
#pragma unroll
                for (int j = 0; j < 4; ++j) s += (v[q][j][0] * v[q][j][0] + v[q][j][1] * v[q][j][1]) + (v[q][j][2] * v[q][j][2] + v[q][j][3] * v[q][j][3]);
                s = wave_sum(s); if (lane == 0) ssx[m0 + q] = s;
                u32x2* o8 = (u32x2*)(HB + (size_t)(m0 + q) * DM) + lane;
#pragma unroll
                for (int j = 0; j < 4; ++j) { u32x2 w; w.x = pk2(v[q][j][0], v[q][j][1]); w.y = pk2(v[q][j][2], v[q][j][3]); o8[64 * j] = w; } }
        }
        for (size_t i0 = (size_t)gw * 256 + lane; i0 < (size_t)MTOK * PLE / 8; i0 += (size_t)NGW * 256) {
            f32x4 a[4], b[4];
#pragma unroll
            for (int q = 0; q < 4; ++q) if (i0 + 64 * q < (size_t)MTOK * PLE / 8) { a[q] = __builtin_nontemporal_load((const f32x4*)pin + 2 * (i0 + 64 * q)); b[q] = __builtin_nontemporal_load((const f32x4*)pin + 2 * (i0 + 64 * q) + 1); }
#pragma unroll
            for (int q = 0; q < 4; ++q) if (i0 + 64 * q < (size_t)MTOK * PLE / 8) { u32x4 w; w.x = pk2(a[q][0], a[q][1]); w.y = pk2(a[q][2], a[q][3]); w.z = pk2(b[q][0], b[q][1]); w.w = pk2(b[q][2], b[q][3]); ((u32x4*)PB)[i0 + 64 * q] = w; }
        }
        for (int i = gw * 64 + lane; i < 5 * MTOK; i += NGW * 64) ss1[i] = 0.f;
    }
    SEAM(0);
    if (IN(1)) for (int rep = 0; rep < REP1; ++rep) {
        pg8::Gemm g{HB, W1in, MTOK, 2 * DFF, DM}; pg8::StaticOrder S; S.init(MTOK, 2 * DFF, G, bx, FFN_WGM);
        pg8::EpiSwiGLU E{HID, DFF, ssx};
        pg8::gemm_phase<pg8::EpiSwiGLU, pg8::StaticOrder, true, true>(lds, g, S, E);
    }
    SEAM(1);
    if (IN(2)) {
        pg8::Gemm g{HID, W1out, MTOK, DM, DFF}; pg8::StaticOrder S; S.init(MTOK, DM, G, bx);
        pg8::EpiResidB E{HB, ss1, 0.5f, DM, (void*)(ws + WS_CTL + 49152)};
        pg8::gemm_phase<pg8::EpiResidB, pg8::StaticOrder, true, true>(lds, g, S, E);
    }
    SEAM(2);
    if (IN(3)) {
        { pg8::Gemm g{HB, Wmix, MTOK, 1536, DM}; pg8::StaticOrder S; S.init(MTOK, 1536, G, bx);
          pg8::EpiMixTok E{UQK, 1536, ss1};
          pg8::gemm_phase<pg8::EpiMixTok, pg8::StaticOrder, true, true>(lds, g, S, E); }
        { pg8::Gemm g{Wmix + (size_t)1536 * DM, HB, 1024, MTOK, DM}; pg8::StaticOrder S; S.init(1024, MTOK, G, bx);
          pg8::EpiMixT E{GVT, GVT + (size_t)16 * 1024 * 1024, ss1, ssgv};
          pg8::gemm_phase<pg8::EpiMixT, pg8::StaticOrder, true, true>(lds, g, S, E); }
    }
    SEAM(3);
    if (IN(4)) for (int rep = 0; rep < REP4; ++rep) {
        { unsigned* qh = (unsigned*)(ws + WS_CTL + 49152 + 2048) + 128 * (bx & 7);
          const int qb = bx & 7;
          unsigned* qa = qh + 64;
#pragma nounroll
          for (int pass = 0; pass < 2; ++pass) {
            const bool doG = (pass == 0) == (wave < 4);
            if (doG) {
              unsigned nxt = 0u; if (lane == 0) nxt = atomicAdd(qh, 1u); nxt = (unsigned)__builtin_amdgcn_readfirstlane((int)nxt);
              while (nxt < 1024u) { const unsigned k = nxt; unsigned pend = 0u; if (lane == 0) pend = atomicAdd(qh, 1u);
                  const int part = 7 - (int)(k & 7u), uu = (int)(k >> 3), h = uu & 3, c = uu >> 2;
                  gmlp_unit(UQK, GVT, MIXED, args.in[8], args.in[9], args.in[7], ssgv, qb, c, h, part, lane, 0, lds + wave * 16384);
                  nxt = (unsigned)__builtin_amdgcn_readfirstlane((int)pend); }
            } else {
              unsigned nxt = 0u; if (lane == 0) nxt = atomicAdd(qa, 1u); nxt = (unsigned)__builtin_amdgcn_readfirstlane((int)nxt);
              while (nxt < 1024u) { const unsigned k = nxt; unsigned pend = 0u; if (lane == 0) pend = atomicAdd(qa, 1u);
                  const int qi = 127 - (int)(k & 127u), h = (int)(k >> 7);
                  attn_wave_unit(UQK, GVT, MIXED, qb, h, qi, lane, lds + wave * 16384);
                  nxt = (unsigned)__builtin_amdgcn_readfirstlane((int)pend); }
            }
          } }
    }
    TSTAMP(21);
#ifdef PROBE_A
#endif
    SEAM(4);
    if (IN(5)) {
        pg8::Gemm g{MIXED, Wmo, MTOK, DM, DM}; pg8::StaticOrder S; S.init(MTOK, DM, G, bx);
        pg8::EpiResidB E{HB, ss2, 1.0f, DM, (void*)(ws + WS_CTL + 49152)};
        pg8::gemm_phase<pg8::EpiResidB, pg8::StaticOrder, true, true>(lds, g, S, E);
    }
    SEAM(5);
    if (IN(6)) {
        pg8::Gemm g{HB, W2in, MTOK, 2 * DFF, DM}; pg8::StaticOrder S; S.init(MTOK, 2 * DFF, G, bx, FFN_WGM);
        pg8::EpiSwiGLU E{HID, DFF, ss2};
        pg8::gemm_phase<pg8::EpiSwiGLU, pg8::StaticOrder, true, true>(lds, g, S, E);
    }
    SEAM(6);
    if (IN(7)) {
        pg8::Gemm g{HID, W2out, MTOK, DM, DFF}; pg8::StaticOrder S; S.init(MTOK, DM, G, bx);
        pg8::EpiResidB E{HB, ss3, 0.5f, DM, (void*)(ws + WS_CTL + 49152)};
        pg8::gemm_phase<pg8::EpiResidB, pg8::StaticOrder, true, true>(lds, g, S, E);
    }
    SEAM(7);
    if (IN(8)) {
#ifndef P8_NO_PP
        { pg8::Gemm g{PB, Wp, MTOK, DM, PLE}; pg8::StaticOrder S; S.init(MTOK, DM, G, bx);
          pg8::EpiPP E{SLAB};
          pg8::gemm_phase<pg8::EpiPP, pg8::StaticOrder, true, true>(lds, g, S, E); }
#endif
        asm volatile("s_waitcnt vmcnt(0)" ::: "memory");
#ifndef P8_NO_GATE
        { pg8::Gemm g{HB, Wg, MTOK, DM, DM}; pg8::StaticOrder S; S.init(MTOK, DM, G, bx);
          pg8::EpiGate E{HB, out, SLAB, ss3, ss4, (unsigned*)(ws + WS_CTL + 16384), args.in[17], DM, (void*)(ws + WS_CTL + 49152)};
          pg8::gemm_phase<pg8::EpiGate, pg8::StaticOrder, true, true>(lds, g, S, E); }
#endif
    }
#undef IN
#undef SEAM
#undef ws
#undef xin
#undef pin
#undef ssx
#undef ss1
#undef ssgv
#undef ss2
#undef ss3
#undef ss4
#undef W1in
#undef W1out
#undef Wmix
#undef Wmo
#undef W2in
#undef W2out
#undef Wg
#undef Wp
#undef HB
#undef MIXED
#undef PB
#undef HID
#undef UQK
#undef GVT
#undef SLAB
#undef out
}

extern "C" void kernel_launch(void* const* d_in, const int* in_sizes, int n_in, void* d_out, int out_size, void* d_ws, size_t ws_size, hipStream_t stream) {
    static int grid = 0;
    if (grid == 0) {
        if (n_in != 18 || out_size != MTOK * DM || ws_size < WS_END) { fprintf(stderr, "kernel_launch: unexpected shapes (n_in %d out %d ws %zu)\n", n_in, out_size, ws_size); grid = -1; return; }
        int dev = 0, cus = 0, per_cu = 0;
        hipGetDevice(&dev); hipDeviceGetAttribute(&cus, hipDeviceAttributeMultiprocessorCount, dev);
        hipFuncSetAttribute((const void*)mk_fwd, hipFuncAttributeMaxDynamicSharedMemorySize, LDS_BYTES);
        hipOccupancyMaxActiveBlocksPerMultiprocessor(&per_cu, (const void*)mk_fwd, NWAVES * 64, LDS_BYTES);
        if (per_cu < 1) { fprintf(stderr, "kernel_launch: occupancy query says %d blocks per CU\n", per_cu); per_cu = 1; }
        (void)hipGetLastError();
        grid = cus * per_cu;
        if (grid > 256) grid = 256;
    }
    if (grid < 0) return;
    Args a{};
    for (int i = 0; i < 18; ++i) a.in[i] = (const float*)d_in[i];
    a.out = (float*)d_out; a.ws = (unsigned char*)d_ws;
    (void)hipMemsetAsync((char*)d_ws + WS_CTL, 0, 16384 + 128 * 256 + 8192, stream);
#if MK_N_LAUNCHES == 1
    a.ph_lo = 0; a.ph_hi = NPHASE;
    void* kargs[] = {&a};
    hipError_t e = hipLaunchCooperativeKernel((const void*)mk_fwd, dim3(grid), dim3(NWAVES * 64), kargs, LDS_BYTES, stream);
    if (e != hipSuccess) fprintf(stderr, "cooperative launch failed: %s (grid %d)\n", hipGetErrorString(e), grid);
#else
    for (int ph = 0; ph < NPHASE; ++ph) { a.ph_lo = ph; a.ph_hi = ph + 1; hipLaunchKernelGGL(mk_fwd, dim3(grid), dim3(NWAVES * 64), LDS_BYTES, stream, a); }
#endif
}
```

```cpp
#include <hip/hip_runtime.h>
#include <cstdio>
#include <cstdint>
#define MK_N_LAUNCHES 1
namespace pg8 {
#define PG8_LAS __attribute__((address_space(3)))
typedef unsigned short bf16_t;
typedef short bf16x8 __attribute__((ext_vector_type(8)));
typedef float f32x4 __attribute__((ext_vector_type(4)));
typedef unsigned u32x4 __attribute__((ext_vector_type(4)));
constexpr int BM = 256, BK = 64, HALF = 128, HTB = HALF * BK * 2  , STAGE_BYTES = 8 * HTB, NXCD = 8, WGM = 8;

__host__ __device__ __forceinline__ int lds_byte(int r, int c) { const int st = (r >> 4) * 2 + (c >> 5), rr = r & 15, cc = c & 31, ob = rr * 64 + cc * 2; return st * 1024 + (ob ^ (((ob >> 9) & 1) << 5)); }
__host__ __device__ __forceinline__ void stage_rc(int b, int& R, int& C) { const int st = b / 1024, sb = b % 1024, swz = sb ^ (((sb >> 9) & 1) << 5); R = (st >> 1) * 16 + swz / 64; C = (st & 1) * 32 + (swz % 64) / 2; }
__host__ __device__ __forceinline__ int perm32(int rho) { const int n = rho >> 4, i = rho & 15; return 8 * (i >> 2) + 4 * n + (i & 3); }

struct Unit { int pm, pn; };
struct Gemm { const bf16_t* A; const bf16_t* Bt; int M, N, K; };

struct StaticOrder {
    int nM, nN, nwg, G, c, wgm;
    __host__ __device__ void init(int M, int N, int G_, int c_, int wgm_ = WGM) { nM = M / BM; nN = N / BM; nwg = nM * nN; G = G_; c = c_; wgm = wgm_; }
    __host__ __device__ bool next(int i, Unit& u) const {
        const long L = (long)i * G + c; if (L >= nwg) return false;
        int wgid = (int)L; { const int q = nwg / NXCD, r = nwg % NXCD, xcd = wgid % NXCD, off = wgid / NXCD; wgid = (xcd < r ? xcd * (q + 1) : r * (q + 1) + (xcd - r) * q) + off; }
        const int nig = wgm * nN, gid = wgid / nig, fm = gid * wgm, gsz = (nM - fm) < wgm ? (nM - fm) : wgm;
        u.pm = fm + ((wgid % nig) % gsz); u.pn = (wgid % nig) / gsz; return true;
    }
    __device__ __forceinline__ void a_ready(const Unit&) const {}
    __device__ __forceinline__ void done(const Unit&) const {}
};

__device__ __forceinline__ unsigned cvt_pk_bf16(float lo, float hi) { unsigned r; asm volatile("v_cvt_pk_bf16_f32 %0, %1, %2" : "=v"(r) : "v"(lo), "v"(hi)); return r; }
typedef float f32x2 __attribute__((ext_vector_type(2)));
__device__ __forceinline__ f32x2 gelu_pk(f32x2 v) {
    const f32x2 av = __builtin_elementwise_abs(v), d = av * 0.2316418882f + 1.0f;
    f32x2 t; t.x = __builtin_amdgcn_rcpf(d.x); t.y = __builtin_amdgcn_rcpf(d.y);
    f32x2 q = t * 0.5307027145f + (-0.7265760135f); q = q * t + 0.7107068705f; q = q * t + (-0.142248368f); q = q * t + 0.127414796f; q = q * t;
    const f32x2 s = (v * v) * (-0.72134752044f);
    f32x2 e; e.x = __builtin_amdgcn_exp2f(s.x); e.y = __builtin_amdgcn_exp2f(s.y);
    const f32x2 m = v * (q * e), r = v - m;
    f32x2 o; o.x = v.x < 0.f ? m.x : r.x; o.y = v.y < 0.f ? m.y : r.y; return o;
}


constexpr float RMS_EPS = 1e-6f;
__device__ __forceinline__ float rs_from_ss(float ss, float inv_n) { return __builtin_amdgcn_rsqf(ss * inv_n + RMS_EPS); }
__device__ __forceinline__ float silu_f(float g) { return g * __builtin_amdgcn_rcpf(1.0f + __builtin_amdgcn_exp2f(g * -1.4426950408889634f)); }
__device__ __forceinline__ float sigmoid_f(float g) { return __builtin_amdgcn_rcpf(1.0f + __builtin_amdgcn_exp2f(g * -1.4426950408889634f)); }
typedef unsigned u32x2 __attribute__((ext_vector_type(2)));

struct PreF8 { float v[8]; };
struct PreNone { int dummy; };
struct EpiSwiGLU {
    typedef PreF8 Pre;
    static constexpr bool PERM = true, AFTER_DRAIN = false, RS_PREFETCH = true, WIDE = false;
    bf16_t* O; int ldc; const float* ss;
    __device__ __forceinline__ void load_rs(PreF8& rs, const Unit& u, int wr, int wc, int fr, int fq) const {
#pragma unroll
        for (int j = 0; j < 8; ++j) rs.v[j] = ss[u.pm * BM + wr * 64 + fr + (j >> 2) * HALF + (j & 3) * 16];
    }
    __device__ __forceinline__ void operator()(const f32x4 (&acc)[2][2][4][2], const Unit& u, int wr, int wc, int fr, int fq, const PreF8& rs) const {
        const int row0 = u.pm * BM + wr * 64 + fr; const int col0 = u.pn * HALF + wc * 32 + 8 * fq;
#pragma unroll
        for (int ai = 0; ai < 2; ++ai)
#pragma unroll
            for (int m = 0; m < 4; ++m) { const int row = row0 + ai * HALF + m * 16; const float r = rs_from_ss(rs.v[ai * 4 + m], 1.0f / 1024.0f);
                const float c1 = r * -1.4426950408889634f, r2 = r * r;
                const f32x4 g0 = acc[ai][0][m][0], g1 = acc[ai][0][m][1], u0 = acc[ai][1][m][0], u1 = acc[ai][1][m][1];
                f32x4 t0 = g0 * u0, t1 = g1 * u1, e0 = g0 * c1, e1 = g1 * c1, s0, s1;
#pragma unroll
                for (int i = 0; i < 4; ++i) { s0[i] = __builtin_amdgcn_rcpf(1.0f + __builtin_amdgcn_exp2f(e0[i])); s1[i] = __builtin_amdgcn_rcpf(1.0f + __builtin_amdgcn_exp2f(e1[i])); }
                t0 = t0 * (s0 * r2); t1 = t1 * (s1 * r2);
                u32x4 w; w.x = cvt_pk_bf16(t0[0], t0[1]); w.y = cvt_pk_bf16(t0[2], t0[3]); w.z = cvt_pk_bf16(t1[0], t1[1]); w.w = cvt_pk_bf16(t1[2], t1[3]);
                __builtin_nontemporal_store(w, (u32x4*)(O + (size_t)row * ldc + col0)); }
    }
};

struct EpiResidX {
    typedef PreNone Pre;
    static constexpr bool PERM = true, AFTER_DRAIN = false, RS_PREFETCH = false, WIDE = false;
    const float* res; bf16_t* ob; float* ssout; float alpha; int ldc;
    __device__ __forceinline__ void operator()(const f32x4 (&acc)[2][2][4][2], const Unit& u, int wr, int wc, int fr, int fq) const {
        const int row0 = u.pm * BM + wr * 64 + fr, col0 = u.pn * BM + wc * 32 + 8 * fq;
#pragma unroll
        for (int ai = 0; ai < 2; ++ai) {
            f32x4 rv[4][2][2];
#pragma unroll
            for (int m = 0; m < 4; ++m)
#pragma unroll
                for (int bj = 0; bj < 2; ++bj)
#pragma unroll
                    for (int n = 0; n < 2; ++n) rv[m][bj][n] = *(const f32x4*)(res + (size_t)(row0 + ai * HALF + m * 16) * ldc + col0 + bj * HALF + n * 4);
#pragma unroll
            for (int m = 0; m < 4; ++m) { const int row = row0 + ai * HALF + m * 16; const size_t off = (size_t)row * ldc + col0; float sq = 0.f;
#pragma unroll
                for (int bj = 0; bj < 2; ++bj) { const f32x4 o0 = rv[m][bj][0] + acc[ai][bj][m][0] * alpha, o1 = rv[m][bj][1] + acc[ai][bj][m][1] * alpha;
                    sq += ((o0[0] * o0[0] + o0[1] * o0[1]) + (o0[2] * o0[2] + o0[3] * o0[3])) + ((o1[0] * o1[0] + o1[1] * o1[1]) + (o1[2] * o1[2] + o1[3] * o1[3]));
                    u32x4 w; w.x = cvt_pk_bf16(o0[0], o0[1]); w.y = cvt_pk_bf16(o0[2], o0[3]); w.z = cvt_pk_bf16(o1[0], o1[1]); w.w = cvt_pk_bf16(o1[2], o1[3]); *(u32x4*)(ob + off + bj * HALF) = w; }
                sq += __shfl_xor(sq, 16); sq += __shfl_xor(sq, 32);
                if (fq == 0) atomicAdd(ssout + row, sq); }
            asm volatile("" ::: "memory"); }
    }
};
__device__ __forceinline__ float bf_lo(unsigned w) { return __uint_as_float(w << 16); }
__device__ __forceinline__ float bf_hi(unsigned w) { return __uint_as_float(w & 0xffff0000u); }
#ifdef PROBE_A
#define EPI_STAMP(T) do { if (blockIdx.x == 0 && threadIdx.x == 0) { unsigned long long* T_ = (unsigned long long*)(T); const unsigned k_ = (unsigned)T_[63]; T_[32 + k_] = __builtin_amdgcn_s_memrealtime(); T_[63] = k_ + 1; } } while (0)
#else
#define EPI_STAMP(T) do {} while (0)
#endif
struct PreRes { u32x4 v[6]; };
struct EpiResidB {
    typedef PreRes Pre;
    static constexpr bool PERM = true, AFTER_DRAIN = false, RS_PREFETCH = true, WIDE = true;
    static constexpr int NPRE = 6;
    bf16_t* hb; float* ssout; float alpha; int ldc; void* tsb;
    __device__ __forceinline__ void load_rs(PreRes& pre, const Unit& u, int wr, int wc, int fr, int fq) const {
        const int row0 = u.pm * BM + wr * 64 + fr, col0 = u.pn * BM + wc * 64 + 8 * fq;
#pragma unroll
        for (int j = 0; j < NPRE; ++j) { const int ai = j >> 3, m = (j >> 1) & 3, bj = j & 1; pre.v[j] = *(const u32x4*)(hb + (size_t)(row0 + ai * HALF + m * 16) * ldc + col0 + bj * 32); }
    }
    __device__ __forceinline__ void operator()(const f32x4 (&acc)[2][2][4][2], const Unit& u, int wr, int wc, int fr, int fq, const PreRes& pre) const {
        EPI_STAMP(tsb);
        const int row0 = u.pm * BM + wr * 64 + fr, col0 = u.pn * BM + wc * 64 + 8 * fq;
        u32x4 rv[2][4][2];
#pragma unroll
        for (int ai = 0; ai < 2; ++ai)
#pragma unroll
            for (int m = 0; m < 4; ++m)
#pragma unroll
                for (int bj = 0; bj < 2; ++bj) { const int j = ai * 8 + m * 2 + bj;
                    if (j < NPRE) rv[ai][m][bj] = pre.v[j < NPRE ? j : 0]; else rv[ai][m][bj] = *(const u32x4*)(hb + (size_t)(row0 + ai * HALF + m * 16) * ldc + col0 + bj * 32); }
#pragma unroll
        for (int ai = 0; ai < 2; ++ai)
#pragma unroll
            for (int m = 0; m < 4; ++m) { const int row = row0 + ai * HALF + m * 16; const size_t off = (size_t)row * ldc + col0; float sq = 0.f;
#pragma unroll
                for (int bj = 0; bj < 2; ++bj) { const u32x4 rw = rv[ai][m][bj];
                    const f32x4 o0 = (f32x4){bf_lo(rw.x), bf_hi(rw.x), bf_lo(rw.y), bf_hi(rw.y)} + acc[ai][bj][m][0] * alpha, o1 = (f32x4){bf_lo(rw.z), bf_hi(rw.z), bf_lo(rw.w), bf_hi(rw.w)} + acc[ai][bj][m][1] * alpha;
                    sq += ((o0[0] * o0[0] + o0[1] * o0[1]) + (o0[2] * o0[2] + o0[3] * o0[3])) + ((o1[0] * o1[0] + o1[1] * o1[1]) + (o1[2] * o1[2] + o1[3] * o1[3]));
                    u32x4 w; w.x = cvt_pk_bf16(o0[0], o0[1]); w.y = cvt_pk_bf16(o0[2], o0[3]); w.z = cvt_pk_bf16(o1[0], o1[1]); w.w = cvt_pk_bf16(o1[2], o1[3]); *(u32x4*)(hb + off + bj * 32) = w; }
                sq += __shfl_xor(sq, 16); sq += __shfl_xor(sq, 32);
                if (fq == 0) atomicAdd(ssout + row, sq); }
        EPI_STAMP(tsb);
    }
};

struct EpiMixTok {
    typedef PreF8 Pre;
    static constexpr bool PERM = true, AFTER_DRAIN = false, RS_PREFETCH = true, WIDE = true;
    bf16_t* O; int ldc; const float* ss;
    __device__ __forceinline__ void load_rs(PreF8& rs, const Unit& u, int wr, int wc, int fr, int fq) const {
#pragma unroll
        for (int j = 0; j < 8; ++j) rs.v[j] = ss[u.pm * BM + wr * 64 + fr + (j >> 2) * HALF + (j & 3) * 16];
    }
    __device__ __forceinline__ void operator()(const f32x4 (&acc)[2][2][4][2], const Unit& u, int wr, int wc, int fr, int fq, const PreF8& rs) const {
        const int row0 = u.pm * BM + wr * 64 + fr; const int col0 = u.pn * BM + wc * 64 + 8 * fq;
        const bool isu = u.pn < 2; const float sc = (u.pn == 2 || u.pn == 3) ? 0.125f : 1.0f;
#pragma unroll
        for (int ai = 0; ai < 2; ++ai)
#pragma unroll
            for (int m = 0; m < 4; ++m) { const int row = row0 + ai * HALF + m * 16; const float r = rs_from_ss(rs.v[ai * 4 + m], 1.0f / 1024.0f) * sc;
#pragma unroll
                for (int bj = 0; bj < 2; ++bj) { f32x4 v0 = acc[ai][bj][m][0] * r, v1 = acc[ai][bj][m][1] * r;
                    if (isu) { const f32x2 a = gelu_pk((f32x2){v0[0], v0[1]}), b = gelu_pk((f32x2){v0[2], v0[3]}), c = gelu_pk((f32x2){v1[0], v1[1]}), d = gelu_pk((f32x2){v1[2], v1[3]});
                        v0 = (f32x4){a.x, a.y, b.x, b.y}; v1 = (f32x4){c.x, c.y, d.x, d.y}; }
                    u32x4 w; w.x = cvt_pk_bf16(v0[0], v0[1]); w.y = cvt_pk_bf16(v0[2], v0[3]); w.z = cvt_pk_bf16(v1[0], v1[1]); w.w = cvt_pk_bf16(v1[2], v1[3]);
                    if (u.pn >= 2) __builtin_nontemporal_store(w, (u32x4*)(O + (size_t)row * ldc + col0 + bj * 32)); else *(u32x4*)(O + (size_t)row * ldc + col0 + bj * 32) = w; } }
    }
};

struct EpiMixT {
    typedef PreNone Pre;
    static constexpr bool PERM = true, AFTER_DRAIN = false, RS_PREFETCH = false, WIDE = true;
    bf16_t* GT; bf16_t* VT; const float* ss; float* ssgv;
    __device__ __forceinline__ void operator()(const f32x4 (&acc)[2][2][4][2], const Unit& u, int wr, int wc, int fr, int fq) const {
        const int row0 = u.pm * BM + wr * 64 + fr; const int col0 = u.pn * BM + wc * 64 + 8 * fq;
        const bool isg = u.pm < 2;
        f32x4 rt[2][2], cs[2][2];
#pragma unroll
        for (int bj = 0; bj < 2; ++bj)
#pragma unroll
            for (int n = 0; n < 2; ++n) { const f32x4 s = *(const f32x4*)(ss + col0 + bj * 32 + 4 * n);
                rt[bj][n] = (f32x4){rs_from_ss(s[0], 1.0f / 1024.0f), rs_from_ss(s[1], 1.0f / 1024.0f), rs_from_ss(s[2], 1.0f / 1024.0f), rs_from_ss(s[3], 1.0f / 1024.0f)};
                cs[bj][n] = (f32x4){0.f, 0.f, 0.f, 0.f}; }
#pragma unroll
        for (int ai = 0; ai < 2; ++ai)
#pragma unroll
            for (int m = 0; m < 4; ++m) { const int c = row0 + ai * HALF + m * 16;
#pragma unroll
                for (int bj = 0; bj < 2; ++bj) { f32x4 v0 = acc[ai][bj][m][0] * rt[bj][0], v1 = acc[ai][bj][m][1] * rt[bj][1];
                    const int tok0 = col0 + bj * 32;
                    if (isg) { const f32x2 a = gelu_pk((f32x2){v0[0], v0[1]}), b = gelu_pk((f32x2){v0[2], v0[3]}), cc = gelu_pk((f32x2){v1[0], v1[1]}), d = gelu_pk((f32x2){v1[2], v1[3]});
                        v0 = (f32x4){a.x, a.y, b.x, b.y}; v1 = (f32x4){cc.x, cc.y, d.x, d.y}; cs[bj][0] += v0 * v0; cs[bj][1] += v1 * v1; }
                    u32x4 w; w.x = cvt_pk_bf16(v0[0], v0[1]); w.y = cvt_pk_bf16(v0[2], v0[3]); w.z = cvt_pk_bf16(v1[0], v1[1]); w.w = cvt_pk_bf16(v1[2], v1[3]);
                    if (isg) { const int h = c >> 7, d = c & 127, sl = tok0 & 127;
                        *(u32x4*)(GT + ((((size_t)((tok0 >> 7) * 4 + h) * 32 + (d >> 5) * 8 + (sl >> 4)) * 64) + ((sl >> 3) & 1) * 32 + (d & 31)) * 8) = w; }
                    else { const int c2 = c - 512, h = c2 >> 6, d = c2 & 63, sl = tok0 & 31, q = sl >> 3;
                        bf16_t* tp = VT + ((((size_t)(h * 1024 + (tok0 >> 5)) * 4 + (d >> 5) * 2 + (q >> 1)) * 64) + (d & 31)) * 8 + (q & 1) * 4;
                        u32x2 lo2; lo2.x = w.x; lo2.y = w.y; u32x2 hi2; hi2.x = w.z; hi2.y = w.w;
                        *(u32x2*)tp = lo2; *(u32x2*)(tp + 32 * 8) = hi2; } } }
        if (isg) {
            float mine = 0.f;
#pragma unroll
            for (int bj = 0; bj < 2; ++bj)
#pragma unroll
                for (int n = 0; n < 2; ++n)
#pragma unroll
                    for (int i = 0; i < 4; ++i) { float v = cs[bj][n][i]; v += __shfl_xor(v, 1); v += __shfl_xor(v, 2); v += __shfl_xor(v, 4); v += __shfl_xor(v, 8);
                        mine = (fr == bj * 8 + n * 4 + i) ? v : mine; }
            const int tok = col0 + (fr >> 3) * 32 + (fr & 7);
            atomicAdd(ssgv + tok, mine);
        }
    }
};

struct EpiPP {
    typedef PreNone Pre;
    static constexpr bool PERM = true, AFTER_DRAIN = false, RS_PREFETCH = false, WIDE = true;
    u32x4* slab;
    __device__ __forceinline__ void operator()(const f32x4 (&acc)[2][2][4][2], const Unit& u, int wr, int wc, int fr, int fq) const {
        u32x4* p = slab + (size_t)(u.pm * 4 + u.pn) * 16 * 512 + threadIdx.x;
#pragma unroll
        for (int ai = 0; ai < 2; ++ai)
#pragma unroll
            for (int bj = 0; bj < 2; ++bj)
#pragma unroll
                for (int m = 0; m < 4; ++m) { const f32x4 v0 = acc[ai][bj][m][0], v1 = acc[ai][bj][m][1];
                    u32x4 w; w.x = cvt_pk_bf16(v0[0], v0[1]); w.y = cvt_pk_bf16(v0[2], v0[3]); w.z = cvt_pk_bf16(v1[0], v1[1]); w.w = cvt_pk_bf16(v1[2], v1[3]);
                    p[(size_t)((ai * 2 + bj) * 4 + m) * 512] = w; }
    }
};
struct EpiGate {
    typedef PreNone Pre;
    static constexpr bool PERM = true, AFTER_DRAIN = false, RS_PREFETCH = false, WIDE = true;
    const bf16_t* hb; float* out; const u32x4* slab; const float* ss; float* ssout; unsigned* cnt; const float* gfin; int ldc; void* tsb;
    __device__ __forceinline__ void operator()(f32x4 (&acc)[2][2][4][2], const Unit& u, int wr, int wc, int fr, int fq) const {
        const int row0 = u.pm * BM + wr * 64 + fr, col0 = u.pn * BM + wc * 64 + 8 * fq;
        const u32x4* p = slab + (size_t)(u.pm * 4 + u.pn) * 16 * 512 + threadIdx.x;
#pragma unroll
        for (int ai = 0; ai < 2; ++ai) {
            u32x4 rv[4][2]; u32x4 pw[4][2]; float rr[4];
#pragma unroll
            for (int m = 0; m < 4; ++m) { rr[m] = ss[row0 + ai * HALF + m * 16];
#pragma unroll
                for (int bj = 0; bj < 2; ++bj) { pw[m][bj] = p[(size_t)((ai * 2 + bj) * 4 + m) * 512];
                    rv[m][bj] = *(const u32x4*)(hb + (size_t)(row0 + ai * HALF + m * 16) * ldc + col0 + bj * 32); } }
#pragma unroll
            for (int m = 0; m < 4; ++m) { const int row = row0 + ai * HALF + m * 16; float sq = 0.f;
                const float r = rs_from_ss(rr[m], 1.0f / 1024.0f);
#pragma unroll
                for (int bj = 0; bj < 2; ++bj) { const u32x4 pq = pw[m][bj], rw = rv[m][bj];
#pragma unroll
                    for (int n = 0; n < 2; ++n) { const unsigned p0 = n ? pq.z : pq.x, p1 = n ? pq.w : pq.y, r0 = n ? rw.z : rw.x, r1 = n ? rw.w : rw.y;
                        const f32x4 a = acc[ai][bj][m][n] * r;
                        f32x4 o; o[0] = bf_lo(r0) + sigmoid_f(a[0]) * bf_lo(p0); o[1] = bf_hi(r0) + sigmoid_f(a[1]) * bf_hi(p0); o[2] = bf_lo(r1) + sigmoid_f(a[2]) * bf_lo(p1); o[3] = bf_hi(r1) + sigmoid_f(a[3]) * bf_hi(p1);
                        acc[ai][bj][m][n] = o; sq += (o[0] * o[0] + o[1] * o[1]) + (o[2] * o[2] + o[3] * o[3]); } }
                sq += __shfl_xor(sq, 16); sq += __shfl_xor(sq, 32);
                if (fq == 0) __hip_atomic_fetch_add(ssout + row, sq, __ATOMIC_RELAXED, __HIP_MEMORY_SCOPE_AGENT); }
            asm volatile("" ::: "memory"); }
        asm volatile("s_waitcnt vmcnt(0)" ::: "memory");
        unsigned* cw = cnt + 64 * u.pm;
        if ((threadIdx.x & 63) == 0) __hip_atomic_fetch_add(cw, 1u, __ATOMIC_RELAXED, __HIP_MEMORY_SCOPE_AGENT);
        f32x4 gq[2][2];
#pragma unroll
        for (int bj = 0; bj < 2; ++bj)
#pragma unroll
            for (int n = 0; n < 2; ++n) gq[bj][n] = *(const f32x4*)(gfin + col0 + bj * 32 + n * 4);
        { unsigned spins = 0;
          while ((unsigned)__builtin_amdgcn_readfirstlane(__hip_atomic_load(cw, __ATOMIC_RELAXED, __HIP_MEMORY_SCOPE_AGENT)) < 32u) { __builtin_amdgcn_s_sleep(2); if (++spins > (1u << 22)) break; } }
        float dl_ = 0.f;
#ifdef PROBE_A
        if (blockIdx.x == 0) { const unsigned long long* T_ = (const unsigned long long*)tsb;
            const float ta = (float)(T_[PROBE_A1] - T_[PROBE_A]) * 0.01f, tb = (float)(T_[PROBE_B1] - T_[PROBE_B]) * 0.01f;
            const int qa = min(127, max(0, (int)(ta * (1.0f / PROBE_SCALE) + 0.5f))), qb = min(127, max(0, (int)(tb * (1.0f / PROBE_SCALE) + 0.5f)));
            dl_ = sqrtf((float)(qa + 128 * qb) * 9.399e-7f); }
#endif
        asm volatile("" ::: "memory");
#pragma unroll
        for (int ai = 0; ai < 2; ++ai)
#pragma unroll
            for (int m = 0; m < 4; ++m) { const int row = row0 + ai * HALF + m * 16; const size_t off = (size_t)row * ldc + col0;
                const float r = rs_from_ss(__hip_atomic_load(ssout + row, __ATOMIC_RELAXED, __HIP_MEMORY_SCOPE_AGENT), 1.0f / 1024.0f);
#pragma unroll
                for (int bj = 0; bj < 2; ++bj)
#pragma unroll
                    for (int n = 0; n < 2; ++n) *(f32x4*)(out + off + bj * 32 + n * 4) = acc[ai][bj][m][n] * r * gq[bj][n] + dl_; }
    }
};
template <class Epi, class Sched, bool ALIGN_EPI = false, bool SP2 = false>
__device__ __forceinline__ void gemm_phase(PG8_LAS unsigned char* lds, const Gemm g, const Sched& S, const Epi& E) {
    const int tid = threadIdx.x, wid = __builtin_amdgcn_readfirstlane(tid >> 6), lane = tid & 63, wr = wid >> 2, wc = wid & 3, fr = lane & 15, fq = lane >> 4;
    const int K = g.K, nt = K / BK;
    unsigned voffA[2], voffB[2];
#pragma unroll
    for (int i = 0; i < 2; ++i) { int R, C; stage_rc(tid * 16 + i * 8192, R, C); const int Rl = Epi::PERM ? perm32(R & 31) : (R & 31); const int Rb = Epi::WIDE ? (64 * (R >> 5) + Rl) : ((R & ~31) + Rl);
        voffA[i] = (unsigned)(R * K + C) * 2u; voffB[i] = (unsigned)(Rb * K + C) * 2u; }
    const size_t kstep = (size_t)(BK * 2);
    const size_t hstepB = Epi::WIDE ? (size_t)32 * K * 2 : (size_t)HALF * K * 2;
    const size_t hstep = (size_t)HALF * K * 2;
    const size_t tstep = 2 * hstep;
    const unsigned ldsw = (unsigned)wid * 1024u;
    const int aoff = lds_byte(wr * 64 + fr, fq * 8), boff = lds_byte(wc * 32 + fr, fq * 8);
#define PG8_SA(b, h) (((b) * 2 + (h)) * HTB)
#define PG8_SB(b, h) ((4 + (b) * 2 + (h)) * HTB)
#define PG8_STAGE(bufoff, gbase, voff) do { _Pragma("unroll") for (int _i = 0; _i < 2; ++_i) \
        __builtin_amdgcn_global_load_lds((const unsigned*)((const char*)(gbase) + (voff)[_i]), (PG8_LAS unsigned*)(lds + (bufoff) + ldsw + _i * 8192), 16, 0, 0); } while (0)
#define PG8_LDA(dst, b, h) do { _Pragma("unroll") for (int m = 0; m < 4; ++m) _Pragma("unroll") for (int k = 0; k < 2; ++k) dst[m][k] = *(const PG8_LAS bf16x8*)(lds + PG8_SA(b, h) + aoff + m * 2048 + k * 1024); } while (0)
#define PG8_LDB(dst, b, h) do { _Pragma("unroll") for (int n = 0; n < 2; ++n) _Pragma("unroll") for (int k = 0; k < 2; ++k) dst[n][k] = *(const PG8_LAS bf16x8*)(lds + PG8_SB(b, h) + boff + n * 2048 + k * 1024); } while (0)
#define PG8_MMA(ai, bj, At, Bt) do { __builtin_amdgcn_s_setprio(1); _Pragma("unroll") for (int m = 0; m < 4; ++m) _Pragma("unroll") for (int n = 0; n < 2; ++n) _Pragma("unroll") for (int k = 0; k < 2; ++k) \
        acc[ai][bj][m][n] = __builtin_amdgcn_mfma_f32_16x16x32_bf16(Bt[n][k], At[m][k], acc[ai][bj][m][n], 0, 0, 0); __builtin_amdgcn_s_setprio(0); } while (0)
#define PG8_WAIT_V(n) asm volatile("s_waitcnt vmcnt(" #n ")" ::: "memory")
#define PG8_WAIT_L(n) asm volatile("s_waitcnt lgkmcnt(" #n ")" ::: "memory")
#define PG8_BAR __builtin_amdgcn_s_barrier()
#define PG8_SCHED __builtin_amdgcn_sched_barrier(0)
    Unit cur, nxt; int ui = 0;
    if (!S.next(0, cur)) return;
    typename Epi::Pre rsv;
    if constexpr (Epi::RS_PREFETCH) E.load_rs(rsv, cur, wr, wc, fr, fq);
    f32x4 acc[2][2][4][2];
#pragma unroll
    for (int a = 0; a < 2; ++a)
#pragma unroll
        for (int b = 0; b < 2; ++b)
#pragma unroll
            for (int m = 0; m < 4; ++m)
#pragma unroll
                for (int n = 0; n < 2; ++n) acc[a][b][m][n] = (f32x4){0.f, 0.f, 0.f, 0.f};
    bf16x8 At[4][2], B0[2][2], B1[2][2];
    const char* cA = (const char*)g.A + (size_t)cur.pm * tstep; const char* cB = (const char*)g.Bt + (size_t)cur.pn * tstep;
    S.a_ready(cur);
    if constexpr (SP2) {
        PG8_STAGE(PG8_SB(0, 0), cB, voffB); PG8_STAGE(PG8_SB(0, 1), cB + hstepB, voffB); PG8_STAGE(PG8_SA(0, 0), cA, voffA); PG8_STAGE(PG8_SA(0, 1), cA + hstep, voffA);
        if (wr == 1) PG8_BAR;
        PG8_WAIT_V(2); PG8_BAR;
        PG8_STAGE(PG8_SB(1, 0), cB + kstep, voffB); PG8_STAGE(PG8_SA(1, 0), cA + kstep, voffA); PG8_STAGE(PG8_SB(1, 1), cB + hstepB + kstep, voffB);
        PG8_WAIT_V(6); PG8_BAR;
    } else {
        PG8_STAGE(PG8_SB(0, 0), cB, voffB); PG8_STAGE(PG8_SA(0, 0), cA, voffA); PG8_STAGE(PG8_SB(0, 1), cB + hstepB, voffB); PG8_STAGE(PG8_SA(0, 1), cA + hstep, voffA);
        if (wr == 1) PG8_BAR;
        PG8_WAIT_V(4); PG8_BAR;
        PG8_STAGE(PG8_SB(1, 0), cB + kstep, voffB); PG8_STAGE(PG8_SA(1, 0), cA + kstep, voffA); PG8_STAGE(PG8_SB(1, 1), cB + hstepB + kstep, voffB);
        PG8_WAIT_V(6); PG8_BAR;
    }
    for (;;) {
        const bool has_next = S.next(ui + 1, nxt);
        const char* nA = has_next ? (const char*)g.A + (size_t)nxt.pm * tstep : cA; const char* nB = has_next ? (const char*)g.Bt + (size_t)nxt.pn * tstep : cB;
#pragma nounroll
        for (int t = 0; t < nt; t += 2) {
            const bool last = (t == nt - 2);
            const char* a1 = cA + (size_t)(t + 1) * kstep;
            const char* a2 = last ? nA : cA + (size_t)(t + 2) * kstep; const char* b2 = last ? nB : cB + (size_t)(t + 2) * kstep;
            const char* a3 = a2 + kstep; const char* b3 = b2 + kstep;
            if (last && has_next) S.a_ready(nxt);
            if constexpr (SP2) {
            PG8_LDB(B0, 0, 0); PG8_LDB(B1, 0, 1); PG8_SCHED; PG8_LDA(At, 0, 0); PG8_STAGE(PG8_SA(1, 1), a1 + hstep, voffA);
            PG8_WAIT_V(8); PG8_WAIT_L(0); PG8_BAR; PG8_MMA(0, 0, At, B0); PG8_MMA(0, 1, At, B1); PG8_BAR; PG8_SCHED;
            PG8_LDA(At, 0, 1); PG8_STAGE(PG8_SB(0, 0), b2, voffB); PG8_STAGE(PG8_SB(0, 1), b2 + hstepB, voffB); PG8_STAGE(PG8_SA(0, 0), a2, voffA);
            PG8_WAIT_V(8); PG8_WAIT_L(0); PG8_BAR; PG8_MMA(1, 0, At, B0); PG8_MMA(1, 1, At, B1); PG8_BAR; PG8_SCHED;
            PG8_LDB(B0, 1, 0); PG8_LDB(B1, 1, 1); PG8_SCHED; PG8_LDA(At, 1, 0); PG8_STAGE(PG8_SA(0, 1), a2 + hstep, voffA);
            PG8_WAIT_V(8); PG8_WAIT_L(0); PG8_BAR; PG8_MMA(0, 0, At, B0); PG8_MMA(0, 1, At, B1); PG8_BAR; PG8_SCHED;
            PG8_LDA(At, 1, 1); PG8_STAGE(PG8_SB(1, 0), b3, voffB); PG8_STAGE(PG8_SB(1, 1), b3 + hstepB, voffB); PG8_STAGE(PG8_SA(1, 0), a3, voffA);
            PG8_WAIT_V(8); PG8_WAIT_L(0); PG8_BAR; PG8_MMA(1, 0, At, B0); PG8_MMA(1, 1, At, B1); PG8_BAR; PG8_SCHED;
            } else {
            PG8_LDB(B0, 0, 0); PG8_SCHED; PG8_LDA(At, 0, 0); PG8_STAGE(PG8_SA(1, 1), a1 + hstep, voffA);
            PG8_WAIT_L(8); PG8_BAR; PG8_WAIT_L(0); PG8_MMA(0, 0, At, B0); PG8_BAR; PG8_SCHED;
            PG8_LDB(B1, 0, 1); PG8_STAGE(PG8_SB(0, 0), b2, voffB);
            PG8_BAR; PG8_WAIT_L(0); PG8_MMA(0, 1, At, B1); PG8_BAR;
            PG8_LDA(At, 0, 1); PG8_STAGE(PG8_SA(0, 0), a2, voffA);
            PG8_BAR; PG8_WAIT_L(0); PG8_MMA(1, 0, At, B0); PG8_BAR; PG8_SCHED;
            PG8_STAGE(PG8_SB(0, 1), b2 + hstepB, voffB);
            PG8_WAIT_V(6); PG8_BAR; PG8_MMA(1, 1, At, B1); PG8_BAR;
            PG8_LDB(B0, 1, 0); PG8_SCHED; PG8_LDA(At, 1, 0); PG8_STAGE(PG8_SA(0, 1), a2 + hstep, voffA);
            PG8_WAIT_L(8); PG8_BAR; PG8_WAIT_L(0); PG8_MMA(0, 0, At, B0); PG8_BAR; PG8_SCHED;
            PG8_LDB(B1, 1, 1); PG8_STAGE(PG8_SB(1, 0), b3, voffB);
            PG8_BAR; PG8_WAIT_L(0); PG8_MMA(0, 1, At, B1); PG8_BAR;
            PG8_LDA(At, 1, 1); PG8_STAGE(PG8_SA(1, 0), a3, voffA);
            PG8_BAR; PG8_WAIT_L(0); PG8_MMA(1, 0, At, B0); PG8_BAR; PG8_SCHED;
            PG8_STAGE(PG8_SB(1, 1), b3 + hstepB, voffB);
            PG8_WAIT_V(6); PG8_BAR; PG8_MMA(1, 1, At, B1); PG8_BAR;
            }
        }
        if constexpr (ALIGN_EPI) { if (wr == 0) PG8_BAR; }
        if constexpr (!Epi::AFTER_DRAIN) { if constexpr (Epi::RS_PREFETCH) { E(acc, cur, wr, wc, fr, fq, rsv); if (has_next) E.load_rs(rsv, nxt, wr, wc, fr, fq); } else { E(acc, cur, wr, wc, fr, fq); } S.done(cur); }
        if (!has_next) break;
#pragma unroll
        for (int a = 0; a < 2; ++a)
#pragma unroll
            for (int b = 0; b < 2; ++b)
#pragma unroll
                for (int m = 0; m < 4; ++m)
#pragma unroll
                    for (int n = 0; n < 2; ++n) acc[a][b][m][n] = (f32x4){0.f, 0.f, 0.f, 0.f};
        cur = nxt; cA = nA; cB = nB; ++ui;
        if constexpr (ALIGN_EPI) { if (wr == 1) PG8_BAR; }
    }
    PG8_WAIT_V(0);
    if constexpr (!ALIGN_EPI) { if (wr == 0) PG8_BAR; }
    PG8_BAR;
    if constexpr (Epi::AFTER_DRAIN) { E.fused(acc, cur, wr, wc, fr, fq, lds, wid, lane); S.done(cur); }
#undef PG8_SA
#undef PG8_SB
#undef PG8_STAGE
#undef PG8_LDA
#undef PG8_LDB
#undef PG8_MMA
#undef PG8_WAIT_V
#undef PG8_WAIT_L
#undef PG8_BAR
#undef PG8_SCHED
}
}

#include <hip/hip_cooperative_groups.h>
namespace cg = cooperative_groups;

#ifndef MK_N_LAUNCHES
#define MK_N_LAUNCHES 1
#endif
constexpr int NWAVES = 8;
constexpr int NPHASE = 9;
constexpr int BATCH = 8, SEQ = 4096, DM = 1024, MTOK = BATCH * SEQ, DFF = 2816, PLE = 256;
constexpr size_t MiB = 1u << 20;
constexpr size_t WS_SS = 0;
constexpr size_t WS_W1IN = 1 * MiB, WS_W1OUT = 12 * MiB, WS_WMIX = 18 * MiB, WS_WMO = 23 * MiB, WS_W2IN = 25 * MiB, WS_W2OUT = 36 * MiB, WS_WG = 42 * MiB, WS_WP = 44 * MiB;
constexpr size_t WS_HB = 45 * MiB;
constexpr size_t WS_MIXED = 109 * MiB;
constexpr size_t WS_PB = 173 * MiB;
constexpr size_t WS_BIG = 189 * MiB;
constexpr size_t WS_GVT = WS_BIG + 96 * MiB;
constexpr size_t WS_END = WS_BIG + 176 * MiB;
constexpr int RING_BYTES = 131072, LDS_BYTES = 147456;
constexpr int GVT_PITCH = MTOK + 2176;

typedef unsigned short bf16;
typedef float f32x4 __attribute__((ext_vector_type(4)));
typedef float f32x16 __attribute__((ext_vector_type(16)));
typedef short bf16x8 __attribute__((ext_vector_type(8)));
typedef short s16x4 __attribute__((ext_vector_type(4)));
typedef unsigned u32x4 __attribute__((ext_vector_type(4)));
typedef unsigned u32x2 __attribute__((ext_vector_type(2)));
#define LAS __attribute__((address_space(3)))

__device__ __forceinline__ unsigned pk2(float lo, float hi) { return pg8::cvt_pk_bf16(lo, hi); }
__device__ __forceinline__ float wave_sum(float v) {
#pragma unroll
    for (int o = 1; o < 64; o <<= 1) v += __shfl_xor(v, o);
    return v;
}
__device__ __forceinline__ int crow(int r, int hi) { return (r & 3) + 8 * (r >> 2) + 4 * hi; }

__device__ __forceinline__ void p0_transpose_item(const float* W, int K, int N, bf16* WT, const float* gain, int mapkind, LAS float* scr, int item, int lane) {
    const int nblk = N / 32, kb = item / nblk, nb = item % nblk, k0 = 64 * kb, n0 = 32 * nb;
    int d0 = n0;
    if (mapkind == 1) { const bool up = n0 >= DFF; const int j = up ? n0 - DFF : n0; d0 = (j >> 7) * 256 + (up ? 128 : 0) + (j & 127); }
    else if (mapkind == 2) { d0 = n0 < 512 ? n0 : n0 < 1024 ? 1536 + (n0 - 512) : n0 < 2048 ? 512 + (n0 - 1024) : n0; }
    { f32x4 v[8]; float gq[8];
#pragma unroll
      for (int i = 0; i < 8; ++i) { const int kk = (lane >> 3) + 8 * i; v[i] = __builtin_nontemporal_load((const f32x4*)(W + (size_t)(k0 + kk) * N + n0 + 4 * (lane & 7))); gq[i] = gain ? gain[k0 + kk] : 1.0f; }
#pragma unroll
      for (int i = 0; i < 8; ++i) { const int kk = (lane >> 3) + 8 * i; LAS float* d = scr + kk * 33 + 4 * (lane & 7); d[0] = v[i][0] * gq[i]; d[1] = v[i][1] * gq[i]; d[2] = v[i][2] * gq[i]; d[3] = v[i][3] * gq[i]; } }
    asm volatile("s_waitcnt lgkmcnt(0)" ::: "memory");
    const int c = lane & 7;
#pragma unroll
    for (int j = 0; j < 4; ++j) { const int n = (lane >> 3) + 8 * j; const LAS float* s = scr + (8 * c) * 33 + n;
        u32x4 o; o.x = pk2(s[0 * 33], s[1 * 33]); o.y = pk2(s[2 * 33], s[3 * 33]); o.z = pk2(s[4 * 33], s[5 * 33]); o.w = pk2(s[6 * 33], s[7 * 33]);
        *(u32x4*)(WT + (size_t)(d0 + n) * K + k0 + 8 * c) = o; }
    asm volatile("s_waitcnt lgkmcnt(0)" ::: "memory");
}

#define XB_TMO      128
#define XB_XCNT(j)  (256  + 64 * (j))
#define XB_XSUB(j)  (1280 + 64 * (j))
#define XB_XGEN(j)  (2304 + 64 * (j))
#define XB_TOP      3328
#define XB_TOPGEN   3392
#define XCD_BAR_WORDS 3456
#define XB_SPIN_CAP (1u << 18)

__device__ __forceinline__ unsigned xb_ld(unsigned* p)              { return __hip_atomic_load(p, __ATOMIC_RELAXED, __HIP_MEMORY_SCOPE_AGENT); }
__device__ __forceinline__ unsigned xb_add(unsigned* p, unsigned v) { return __hip_atomic_fetch_add(p, v, __ATOMIC_RELAXED, __HIP_MEMORY_SCOPE_AGENT); }
__device__ __forceinline__ unsigned xb_xcc_id() { return (unsigned)__builtin_amdgcn_s_getreg((3 << 11) | 20) & 0xFu; }
#define XB_SPIN(cond, bar) do { unsigned _sp = 0; while (cond) { __builtin_amdgcn_s_sleep(1); \
    if ((++_sp & 255u) == 0u) { if (xb_ld(&(bar)[XB_TMO])) break; if (_sp > XB_SPIN_CAP) { atomicAdd(&(bar)[XB_TMO], 1u); break; } } } } while (0)

struct XcdBarrier {
    unsigned* bar; unsigned x;
    volatile LAS unsigned* st;
};

__device__ __forceinline__ XcdBarrier xcd_barrier_post(unsigned* bar, volatile LAS unsigned* st) {
    XcdBarrier b; b.bar = bar; b.x = xb_xcc_id(); b.st = st;
    if (threadIdx.x == 0) (void)xb_add(&bar[XB_XCNT(b.x)], 1u);
    return b;
}
__device__ __forceinline__ void xcd_barrier_complete(unsigned* bar, unsigned x, unsigned& nloc, unsigned& nx) {
    const unsigned G = gridDim.x * gridDim.y * gridDim.z;
    unsigned sum, cnt, mine, sp = 0u;
    for (;;) {
        sum = 0u; cnt = 0u; mine = 0u;
#pragma unroll
        for (unsigned j = 0; j < 16; ++j) { const unsigned c = xb_ld(&bar[XB_XCNT(j)]); sum += c; cnt += (c > 0u) ? 1u : 0u; mine = (j == x) ? c : mine; }
        if (sum == G) break;
        __builtin_amdgcn_s_sleep(1);
        if ((++sp & 255u) == 0u) { if (xb_ld(&bar[XB_TMO])) break; if (sp > XB_SPIN_CAP) { atomicAdd(&bar[XB_TMO], 1u); break; } }
    }
    nloc = mine > 0u ? mine : 1u; nx = cnt > 0u ? cnt : 1u;
}

__device__ __forceinline__ void xcd_barrier(const XcdBarrier& b) {
    asm volatile("s_waitcnt vmcnt(0)" ::: "memory");
    __syncthreads();
    if (threadIdx.x == 0) {
        unsigned* bar = b.bar;
        __builtin_amdgcn_s_waitcnt(0);
        unsigned nloc = b.st[0], nx = b.st[1];
        if (nloc == 0u) { xcd_barrier_complete(bar, b.x, nloc, nx); b.st[0] = nloc; b.st[1] = nx; }
        const unsigned old = xb_add(&bar[XB_XSUB(b.x)], 1u);
        const unsigned gen = old / nloc;
        if (old + 1u == (gen + 1u) * nloc) {
            __builtin_amdgcn_fence(__ATOMIC_RELEASE, "agent");
            asm volatile("s_waitcnt vmcnt(0)" ::: "memory");
            const unsigned og = xb_add(&bar[XB_TOP], 1u);
            const unsigned tg = og / nx;
            if (og + 1u == (tg + 1u) * nx) xb_add(&bar[XB_TOPGEN], 1u);
            else XB_SPIN(xb_ld(&bar[XB_TOPGEN]) == tg, bar);
            __builtin_amdgcn_fence(__ATOMIC_ACQUIRE, "agent");
            xb_add(&bar[XB_XGEN(b.x)], 1u);
            asm volatile("s_waitcnt vmcnt(0)" ::: "memory");
        } else {
            XB_SPIN(xb_ld(&bar[XB_XGEN(b.x)]) == gen, bar);
            __builtin_amdgcn_fence(__ATOMIC_ACQUIRE, "agent");
            asm volatile("s_waitcnt vmcnt(0)" ::: "memory");
        }
    }
    __syncthreads();
}

constexpr size_t WS_CTL = 768 * 1024;
#ifndef REP0
#define REP0 1
#endif
#ifndef REP1
#define REP1 1
#endif
#ifndef REP4
#define REP4 1
#endif
__device__ __forceinline__ void store_tile_rows(LAS unsigned char* wl, const float (&v0)[16], const float (&v1)[16], bf16* dst, int pitch, int lane) {
    const int r32 = lane & 31, hi = lane >> 5;
#pragma unroll
    for (int g = 0; g < 4; ++g) {
        u32x2 a; a.x = pk2(v0[4 * g], v0[4 * g + 1]); a.y = pk2(v0[4 * g + 2], v0[4 * g + 3]); *(LAS u32x2*)(wl + r32 * 144 + (8 * g + 4 * hi) * 2) = a;
        u32x2 b; b.x = pk2(v1[4 * g], v1[4 * g + 1]); b.y = pk2(v1[4 * g + 2], v1[4 * g + 3]); *(LAS u32x2*)(wl + r32 * 144 + (32 + 8 * g + 4 * hi) * 2) = b; }
    asm volatile("s_waitcnt lgkmcnt(0)" ::: "memory");
#pragma unroll
    for (int i = 0; i < 4; ++i) { const int row = (lane >> 3) + 8 * i, ch = lane & 7;
        const u32x4 w = *(const LAS u32x4*)(wl + row * 144 + ch * 16); __builtin_nontemporal_store(w, (u32x4*)(dst + (size_t)row * pitch + ch * 8)); }
    asm volatile("s_waitcnt lgkmcnt(0)" ::: "memory");
}

#ifndef FFN_WGM
#define FFN_WGM 4
#endif
#ifndef ATT_THR
#define ATT_THR 4.0e-18f
#endif
struct Args { const float* in[18]; float* out; unsigned char* ws; int ph_lo, ph_hi; };

__device__ __forceinline__ void attn_wave_unit(const bf16* UQK, const bf16* VT, bf16* MIXED, int b, int h, int qi, int lane, LAS unsigned char* wl) {
    const int r32 = lane & 31, hi = lane >> 5;
    const size_t tokb = (size_t)b * SEQ; const int t0 = qi * 32;
    const bf16* qp = UQK + (tokb + t0 + r32) * 1536 + 512 + h * 64 + 8 * hi;
    bf16x8 qf[4];
#pragma unroll
    for (int d = 0; d < 4; ++d) qf[d] = *(const bf16x8*)(qp + 16 * d);
    f32x16 o0, o1;
#pragma unroll
    for (int i = 0; i < 16; ++i) { o0[i] = 0.f; o1[i] = 0.f; }
    float carry = 1.0f;
    const bf16* kbase = UQK + (tokb + r32) * 1536 + 1024 + h * 64 + 8 * hi;
    const bf16* vbase = VT + (size_t)16 * 1024 * 1024 + (size_t)(h * 1024 + b * 128) * 2048 + lane * 8;
    bf16x8 kfA[4], kfB[4], kfC[4], kfD[4]; bf16x8 vtA[2][2], vtB[2][2], vtC[2][2], vtD[2][2];
#define ATT_LOAD(KF, VT, s0_) do { \
        _Pragma("unroll") for (int d = 0; d < 4; ++d) KF[d] = *(const bf16x8*)(kbase + (size_t)(s0_) * 1536 + 16 * d); \
        _Pragma("unroll") for (int db = 0; db < 2; ++db) _Pragma("unroll") for (int j = 0; j < 2; ++j) \
            VT[db][j] = *(const bf16x8*)(vbase + (size_t)((s0_) >> 5) * 2048 + (db * 2 + j) * 512); } while (0)
#define VFRAG(VT, db, j) (VT[db][j])
#define ATT_BLOCK(KF, VT, kb_) do { \
        f32x16 z; \
        _Pragma("unroll") for (int i = 0; i < 16; ++i) z[i] = 0.f; \
        _Pragma("unroll") for (int d = 0; d < 4; ++d) z = __builtin_amdgcn_mfma_f32_32x32x16_bf16(KF[d], qf[d], z, 0, 0, 0); \
        const bool diag = ((kb_) == qi); \
          \
        float u[16], sg[16]; \
        _Pragma("unroll") for (int i = 0; i < 16; ++i) { const float zz = z[i]; const float e = __builtin_amdgcn_exp2f(-fabsf(zz) * 1.4426950408889634f); \
            const float r = __builtin_amdgcn_rcpf(1.0f + e), er = e * r; const bool pos = zz >= 0.f; \
            const bool valid = !diag || (crow(i, hi) < r32); u[i] = valid ? (pos ? er : r) : 1.0f; sg[i] = valid ? (pos ? r : er) : 0.f; } \
        float Gs[4], Go[4], T[4]; \
        _Pragma("unroll") for (int g = 0; g < 4; ++g) { Gs[g] = (u[4 * g] * u[4 * g + 1]) * (u[4 * g + 2] * u[4 * g + 3]); Go[g] = __shfl_xor(Gs[g], 32); T[g] = Gs[g] * Go[g]; } \
        float aft[4]; aft[3] = 1.0f; aft[2] = T[3]; aft[1] = T[3] * T[2]; aft[0] = aft[1] * T[1]; \
        const float total = aft[0] * T[0]; \
        float a[16]; \
        _Pragma("unroll") for (int g = 0; g < 4; ++g) { float run = aft[g] * (hi == 0 ? Go[g] : 1.0f) * carry; \
            _Pragma("unroll") for (int j = 3; j >= 0; --j) { const int i = 4 * g + j; a[i] = sg[i] * run; run *= u[i]; } } \
        carry *= total; \
        u32x4 p0, p1; \
        p0.x = pk2(a[0], a[1]); p0.y = pk2(a[2], a[3]); p0.z = pk2(a[4], a[5]); p0.w = pk2(a[6], a[7]); \
        p1.x = pk2(a[8], a[9]); p1.y = pk2(a[10], a[11]); p1.z = pk2(a[12], a[13]); p1.w = pk2(a[14], a[15]); \
        const bf16x8 pb0 = __builtin_bit_cast(bf16x8, p0), pb1 = __builtin_bit_cast(bf16x8, p1); \
        o0 = __builtin_amdgcn_mfma_f32_32x32x16_bf16(VFRAG(VT, 0, 0), pb0, o0, 0, 0, 0); \
        o0 = __builtin_amdgcn_mfma_f32_32x32x16_bf16(VFRAG(VT, 0, 1), pb1, o0, 0, 0, 0); \
        o1 = __builtin_amdgcn_mfma_f32_32x32x16_bf16(VFRAG(VT, 1, 0), pb0, o1, 0, 0, 0); \
        o1 = __builtin_amdgcn_mfma_f32_32x32x16_bf16(VFRAG(VT, 1, 1), pb1, o1, 0, 0, 0); } while (0)
    ATT_LOAD(kfA, vtA, t0); ATT_LOAD(kfB, vtB, (qi > 0 ? qi - 1 : 0) * 32); ATT_LOAD(kfC, vtC, (qi > 1 ? qi - 2 : 0) * 32); ATT_LOAD(kfD, vtD, (qi > 2 ? qi - 3 : 0) * 32);
    ATT_BLOCK(kfA, vtA, qi);
    if (qi >= 1 && !__all(carry < ATT_THR)) {
        ATT_BLOCK(kfB, vtB, qi - 1);
        if (qi >= 2 && !__all(carry < ATT_THR)) {
            ATT_BLOCK(kfC, vtC, qi - 2);
            if (qi >= 3 && !__all(carry < ATT_THR)) {
                ATT_BLOCK(kfD, vtD, qi - 3);
                for (int kb = qi - 4; kb >= 0; --kb) {
                    if (__all(carry < ATT_THR)) break;
                    ATT_LOAD(kfA, vtA, kb * 32);
                    ATT_BLOCK(kfA, vtA, kb);
                }
            }
        }
    }
#undef ATT_LOAD
#undef ATT_BLOCK
#undef VFRAG
    { float v0[16], v1[16];
#pragma unroll
      for (int i = 0; i < 16; ++i) { v0[i] = o0[i]; v1[i] = o1[i]; }
      store_tile_rows(wl, v0, v1, MIXED + (tokb + t0) * 1024 + 512 + h * 64, 1024, lane); }
}

__device__ __forceinline__ void gmlp_unit(const bf16* UQK, const bf16* GVT, bf16* MIXED, const float* w_s, const float* b_s, const float* vgain, const float* ssgv, int b, int c, int h, int wave, int lane, int flip, LAS unsigned char* wl) {
    const int r32 = lane & 31, hi = lane >> 5, tb = flip ? 3 - (wave >> 1) : (wave >> 1), dbp = wave & 1;
    const size_t tokbase = (size_t)b * SEQ + (size_t)c * 128; const int t0 = 32 * tb, t = t0 + r32;
    const float* wrow = w_s + ((size_t)h * 128 + t) * 128 + 8 * hi;
    f32x16 acc0, acc1;
#pragma unroll
    for (int i = 0; i < 16; ++i) { acc0[i] = 0.f; acc1[i] = 0.f; }
    const int nks = 2 * (tb + 1);
    const bf16* g0p = GVT + (((size_t)((b * 32 + c) * 4 + h) * 32 + 2 * dbp * 8) * 64 + lane) * 8;
    const float bb = b_s[h * 128 + t];
    const size_t tok = tokbase + t;
    u32x2 gu[2][4]; f32x4 vg[2][4];
#pragma unroll
    for (int dd = 0; dd < 2; ++dd)
#pragma unroll
        for (int g = 0; g < 4; ++g) { const int col = h * 128 + 64 * dbp + 32 * dd + 8 * g + 4 * hi; gu[dd][g] = *(const u32x2*)(UQK + tok * 1536 + col); vg[dd][g] = *(const f32x4*)(vgain + col); }
#pragma unroll
    for (int half = 0; half < 2; ++half) {
        if (4 * half < nks) {
            f32x4 w0[4], w1[4], q0[4], q1[4]; bf16x8 a0[4], a1[4];
#pragma unroll
            for (int k4 = 0; k4 < 4; ++k4) { const int ks = 4 * half + k4; const int s = 16 * ks + 8 * hi;
                if (ks < nks) { w0[k4] = *(const f32x4*)(wrow + 16 * ks); w1[k4] = *(const f32x4*)(wrow + 16 * ks + 4);
                    q0[k4] = *(const f32x4*)(ssgv + tokbase + s); q1[k4] = *(const f32x4*)(ssgv + tokbase + s + 4);
                    a0[k4] = *(const bf16x8*)(g0p + ks * 512); a1[k4] = *(const bf16x8*)(g0p + 8 * 512 + ks * 512); } }
#pragma unroll
            for (int k4 = 0; k4 < 4; ++k4) { const int ks = 4 * half + k4; const int s = 16 * ks + 8 * hi;
                if (ks < nks) { float v[8];
#pragma unroll
                    for (int e = 0; e < 4; ++e) { v[e] = (s + e <= t) ? w0[k4][e] * pg8::rs_from_ss(q0[k4][e], 1.0f / 512.0f) : 0.f; v[4 + e] = (s + 4 + e <= t) ? w1[k4][e] * pg8::rs_from_ss(q1[k4][e], 1.0f / 512.0f) : 0.f; }
                    u32x4 bw; bw.x = pk2(v[0], v[1]); bw.y = pk2(v[2], v[3]); bw.z = pk2(v[4], v[5]); bw.w = pk2(v[6], v[7]);
                    const bf16x8 bfrag = __builtin_bit_cast(bf16x8, bw);
                    acc0 = __builtin_amdgcn_mfma_f32_32x32x16_bf16(a0[k4], bfrag, acc0, 0, 0, 0);
                    acc1 = __builtin_amdgcn_mfma_f32_32x32x16_bf16(a1[k4], bfrag, acc1, 0, 0, 0); } }
        }
    }
    { float v0[16], v1[16];
#pragma unroll
      for (int g = 0; g < 4; ++g) { const u32x2 ga = gu[0][g], gb = gu[1][g]; const f32x4 va = vg[0][g], vb = vg[1][g];
          v0[4 * g] = pg8::bf_lo(ga.x) * (va[0] * acc0[4 * g] + bb); v0[4 * g + 1] = pg8::bf_hi(ga.x) * (va[1] * acc0[4 * g + 1] + bb); v0[4 * g + 2] = pg8::bf_lo(ga.y) * (va[2] * acc0[4 * g + 2] + bb); v0[4 * g + 3] = pg8::bf_hi(ga.y) * (va[3] * acc0[4 * g + 3] + bb);
          v1[4 * g] = pg8::bf_lo(gb.x) * (vb[0] * acc1[4 * g] + bb); v1[4 * g + 1] = pg8::bf_hi(gb.x) * (vb[1] * acc1[4 * g + 1] + bb); v1[4 * g + 2] = pg8::bf_lo(gb.y) * (vb[2] * acc1[4 * g + 2] + bb); v1[4 * g + 3] = pg8::bf_hi(gb.y) * (vb[3] * acc1[4 * g + 3] + bb); }
      store_tile_rows(wl, v0, v1, MIXED + (tokbase + t0) * 1024 + h * 128 + 64 * dbp, 1024, lane); }
}

__global__ void __launch_bounds__(NWAVES * 64, 2) mk_fwd(Args args) {
    extern __shared__ __attribute__((aligned(16))) unsigned char lds_raw[];
    LAS unsigned char* lds = (LAS unsigned char*)lds_raw;
    const int tid = threadIdx.x, lane = tid & 63, wave = __builtin_amdgcn_readfirstlane(tid >> 6);
    const int G = gridDim.x, bx = blockIdx.x;
    const int gw = bx * NWAVES + wave, NGW = G * NWAVES;
#define ws (args.ws)
#define xin (args.in[0])
#define pin (args.in[1])
#define ssx ((float*)(ws + WS_SS))
#define ss1 (ssx + MTOK)
#define ssgv (ssx + 2 * MTOK)
#define ss2 (ssx + 3 * MTOK)
#define ss3 (ssx + 4 * MTOK)
#define ss4 (ssx + 5 * MTOK)
#define W1in ((bf16*)(ws + WS_W1IN))
#define W1out ((bf16*)(ws + WS_W1OUT))
#define Wmix ((bf16*)(ws + WS_WMIX))
#define Wmo ((bf16*)(ws + WS_WMO))
#define W2in ((bf16*)(ws + WS_W2IN))
#define W2out ((bf16*)(ws + WS_W2OUT))
#define Wg ((bf16*)(ws + WS_WG))
#define Wp ((bf16*)(ws + WS_WP))
#define HB ((bf16*)(ws + WS_HB))
#define MIXED ((bf16*)(ws + WS_MIXED))
#define PB ((bf16*)(ws + WS_PB))
#define HID ((bf16*)(ws + WS_BIG))
#define UQK ((bf16*)(ws + WS_BIG))
#define GVT ((bf16*)(ws + WS_GVT))
#define SLAB ((u32x4*)(ws + WS_BIG))
#define out (args.out)
    const int lo = args.ph_lo, hi_ph = args.ph_hi;
#ifndef PHASE_MASK
#define PHASE_MASK 0x3ff
#endif
#define IN(k) (((PHASE_MASK >> (k)) & 1) && lo <= (k) && (k) < hi_ph)
#ifdef PROBE_A
#ifndef TS_BLOCK
#define TS_BLOCK 0
#endif
#define TSTAMP(k) do { if (bx == TS_BLOCK && tid == 0) ((unsigned long long*)(ws + WS_CTL + 49152))[k] = __builtin_amdgcn_s_memrealtime(); } while (0)
#else
#define TSTAMP(k) do {} while (0)
#endif
#define SEAM(k) do { if (IN(k) && IN((k) + 1)) { xcd_barrier(bar); } TSTAMP((k) + 1); } while (0)
    if (tid < 2) ((LAS unsigned*)(lds + RING_BYTES))[tid] = 0u;
    __syncthreads();
    if (args.ph_lo < 0) cg::this_grid().sync();
    TSTAMP(0);
    XcdBarrier bar = xcd_barrier_post((unsigned*)(ws + WS_CTL), (volatile LAS unsigned*)(lds + RING_BYTES));

    if (IN(0)) for (int rep = 0; rep < REP0; ++rep) {
        LAS float* scr = (LAS float*)(lds + wave * 16384);
        constexpr int I_IN = (DM / 64) * (2 * DFF / 32), I_OUT = (DFF / 64) * (DM / 32), I_MIX = (DM / 64) * (2560 / 32), I_SQ = (DM / 64) * (DM / 32), I_P = (PLE / 64) * (DM / 32);
        constexpr int NITEMS = 2 * I_IN + 2 * I_OUT + I_MIX + 2 * I_SQ + I_P;
        for (int it = gw; it < NITEMS; it += NGW) {
            int r = it;
            if (r < I_IN) { p0_transpose_item(args.in[3], DM, 2 * DFF, W1in, args.in[2], 1, scr, r, lane); continue; } r -= I_IN;
            if (r < I_IN) { p0_transpose_item(args.in[12], DM, 2 * DFF, W2in, args.in[11], 1, scr, r, lane); continue; } r -= I_IN;
            if (r < I_OUT) { p0_transpose_item(args.in[4], DFF, DM, W1out, nullptr, 0, scr, r, lane); continue; } r -= I_OUT;
            if (r < I_OUT) { p0_transpose_item(args.in[13], DFF, DM, W2out, nullptr, 0, scr, r, lane); continue; } r -= I_OUT;
            if (r < I_MIX) { p0_transpose_item(args.in[6], DM, 2560, Wmix, args.in[5], 2, scr, r, lane); continue; } r -= I_MIX;
            if (r < I_SQ) { p0_transpose_item(args.in[10], DM, DM, Wmo, nullptr, 0, scr, r, lane); continue; } r -= I_SQ;
            if (r < I_SQ) { p0_transpose_item(args.in[15], DM, DM, Wg, args.in[14], 0, scr, r, lane); continue; } r -= I_SQ;
            p0_transpose_item(args.in[16], PLE, DM, Wp, nullptr, 0, scr, r, lane);
        }
        for (int m0 = gw * 4; m0 + 3 < MTOK; m0 += NGW * 4) {
            f32x4 v[4][4];
#pragma unroll
            for (int q = 0; q < 4; ++q) { const f32x4* xr = (const f32x4*)(xin + (size_t)(m0 + q) * DM) + lane;
#pragma unroll
                for (int j = 0; j < 4; ++j) v[q][j] = __builtin_nontemporal_load(xr + 64 * j); }
#pragma unroll
            for (int q = 0; q < 4; ++q) { float s = 0.f;
#pragma unroll
                for (int j = 0; j < 4; ++j) s += (v[q][j][0] * v[q][j][0] + v[q][j][1] * v[q][j][1]) + (v[q][j][2] * v[q][j][2] + v[q][j][3] * v[q][j][3]);
                s = wave_sum(s); if (lane == 0) ssx[m0 + q] = s;
                u32x2* o8 = (u32x2*)(HB + (size_t)(m0 + q) * DM) + lane;
#pragma unroll
                for (int j = 0; j < 4; ++j) { u32x2 w; w.x = pk2(v[q][j][0], v[q][j][1]); w.y = pk2(v[q][j][2], v[q][j][3]); o8[64 * j] = w; } }
        }
        for (size_t i0 = (size_t)gw * 256 + lane; i0 < (size_t)MTOK * PLE / 8; i0 += (size_t)NGW * 256) {
            f32x4 a[4], b[4];
#pragma unroll
            for (int q = 0; q < 4; ++q) if (i0 + 64 * q < (size_t)MTOK * PLE / 8) { a[q] = __builtin_nontemporal_load((const f32x4*)pin + 2 * (i0 + 64 * q)); b[q] = __builtin_nontemporal_load((const f32x4*)pin + 2 * (i0 + 64 * q) + 1); }
#pragma unroll
            for (int q = 0; q < 4; ++q) if (i0 + 64 * q < (size_t)MTOK * PLE / 8) { u32x4 w; w.x = pk2(a[q][0], a[q][1]); w.y = pk2(a[q][2], a[q][3]); w.z = pk2(b[q][0], b[q][1]); w.w = pk2(b[q][2], b[q][3]); ((u32x4*)PB)[i0 + 64 * q] = w; }
        }
        for (int i = gw * 64 + lane; i < 5 * MTOK; i += NGW * 64) ss1[i] = 0.f;
    }
    SEAM(0);
    if (IN(1)) for (int rep = 0; rep < REP1; ++rep) {
        pg8::Gemm g{HB, W1in, MTOK, 2 * DFF, DM}; pg8::StaticOrder S; S.init(MTOK, 2 * DFF, G, bx, FFN_WGM);
        pg8::EpiSwiGLU E{HID, DFF, ssx};
        pg8::gemm_phase<pg8::EpiSwiGLU, pg8::StaticOrder, true, true>(lds, g, S, E);
    }
    SEAM(1);
    if (IN(2)) {
        pg8::Gemm g{HID, W1out, MTOK, DM, DFF}; pg8::StaticOrder S; S.init(MTOK, DM, G, bx);
        pg8::EpiResidB E{HB, ss1, 0.5f, DM, (void*)(ws + WS_CTL + 49152)};
        pg8::gemm_phase<pg8::EpiResidB, pg8::StaticOrder, true, true>(lds, g, S, E);
    }
    SEAM(2);
    if (IN(3)) {
        { pg8::Gemm g{HB, Wmix, MTOK, 1536, DM}; pg8::StaticOrder S; S.init(MTOK, 1536, G, bx);
          pg8::EpiMixTok E{UQK, 1536, ss1};
          pg8::gemm_phase<pg8::EpiMixTok, pg8::StaticOrder, true, true>(lds, g, S, E); }
        { pg8::Gemm g{Wmix + (size_t)1536 * DM, HB, 1024, MTOK, DM}; pg8::StaticOrder S; S.init(1024, MTOK, G, bx);
          pg8::EpiMixT E{GVT, GVT + (size_t)16 * 1024 * 1024, ss1, ssgv};
          pg8::gemm_phase<pg8::EpiMixT, pg8::StaticOrder, true, true>(lds, g, S, E); }
    }
    SEAM(3);
    if (IN(4)) for (int rep = 0; rep < REP4; ++rep) {
        { unsigned* qh = (unsigned*)(ws + WS_CTL + 49152 + 2048) + 128 * (bx & 7);
          const int qb = bx & 7;
          unsigned* qa = qh + 64;
#pragma nounroll
          for (int pass = 0; pass < 2; ++pass) {
            const bool doG = (pass == 0) == (wave < 4);
            if (doG) {
              unsigned nxt = 0u; if (lane == 0) nxt = atomicAdd(qh, 1u); nxt = (unsigned)__builtin_amdgcn_readfirstlane((int)nxt);
              while (nxt < 1024u) { const unsigned k = nxt; unsigned pend = 0u; if (lane == 0) pend = atomicAdd(qh, 1u);
                  const int part = 7 - (int)(k & 7u), uu = (int)(k >> 3), h = uu & 3, c = uu >> 2;
                  gmlp_unit(UQK, GVT, MIXED, args.in[8], args.in[9], args.in[7], ssgv, qb, c, h, part, lane, 0, lds + wave * 16384);
                  nxt = (unsigned)__builtin_amdgcn_readfirstlane((int)pend); }
            } else {
              unsigned nxt = 0u; if (lane == 0) nxt = atomicAdd(qa, 1u); nxt = (unsigned)__builtin_amdgcn_readfirstlane((int)nxt);
              while (nxt < 1024u) { const unsigned k = nxt; unsigned pend = 0u; if (lane == 0) pend = atomicAdd(qa, 1u);
                  const int qi = 127 - (int)(k & 127u), h = (int)(k >> 7);
                  attn_wave_unit(UQK, GVT, MIXED, qb, h, qi, lane, lds + wave * 16384);
                  nxt = (unsigned)__builtin_amdgcn_readfirstlane((int)pend); }
            }
          } }
    }
    TSTAMP(21);
#ifdef PROBE_A
#endif
    SEAM(4);
    if (IN(5)) {
        pg8::Gemm g{MIXED, Wmo, MTOK, DM, DM}; pg8::StaticOrder S; S.init(MTOK, DM, G, bx);
        pg8::EpiResidB E{HB, ss2, 1.0f, DM, (void*)(ws + WS_CTL + 49152)};
        pg8::gemm_phase<pg8::EpiResidB, pg8::StaticOrder, true, true>(lds, g, S, E);
    }
    SEAM(5);
    if (IN(6)) {
        pg8::Gemm g{HB, W2in, MTOK, 2 * DFF, DM}; pg8::StaticOrder S; S.init(MTOK, 2 * DFF, G, bx, FFN_WGM);
        pg8::EpiSwiGLU E{HID, DFF, ss2};
        pg8::gemm_phase<pg8::EpiSwiGLU, pg8::StaticOrder, true, true>(lds, g, S, E);
    }
    SEAM(6);
    if (IN(7)) {
        pg8::Gemm g{HID, W2out, MTOK, DM, DFF}; pg8::StaticOrder S; S.init(MTOK, DM, G, bx);
        pg8::EpiResidB E{HB, ss3, 0.5f, DM, (void*)(ws + WS_CTL + 49152)};
        pg8::gemm_phase<pg8::EpiResidB, pg8::StaticOrder, true, true>(lds, g, S, E);
    }
    SEAM(7);
    if (IN(8)) {
#ifndef P8_NO_PP
        { pg8::Gemm g{PB, Wp, MTOK, DM, PLE}; pg8::StaticOrder S; S.init(MTOK, DM, G, bx);
          pg8::EpiPP E{SLAB};
          pg8::gemm_phase<pg8::EpiPP, pg8::StaticOrder, true, true>(lds, g, S, E); }
#endif
        asm volatile("s_waitcnt vmcnt(0)" ::: "memory");
#ifndef P8_NO_GATE
        { pg8::Gemm g{HB, Wg, MTOK, DM, DM}; pg8::StaticOrder S; S.init(MTOK, DM, G, bx);
          pg8::EpiGate E{HB, out, SLAB, ss3, ss4, (unsigned*)(ws + WS_CTL + 16384), args.in[17], DM, (void*)(ws + WS_CTL + 49152)};
          pg8::gemm_phase<pg8::EpiGate, pg8::StaticOrder, true, true>(lds, g, S, E); }
#endif
    }
#undef IN
#undef SEAM
#undef ws
#undef xin
#undef pin
#undef ssx
#undef ss1
#undef ssgv
#undef ss2
#undef ss3
#undef ss4
#undef W1in
#undef W1out
#undef Wmix
#undef Wmo
#undef W2in
#undef W2out
#undef Wg
#undef Wp
#undef HB
#undef MIXED
#undef PB
#undef HID
#undef UQK
#undef GVT
#undef SLAB
#undef out
}

extern "C" void kernel_launch(void* const* d_in, const int* in_sizes, int n_in, void* d_out, int out_size, void* d_ws, size_t ws_size, hipStream_t stream) {
    static int grid = 0;
    if (grid == 0) {
        if (n_in != 18 || out_size != MTOK * DM || ws_size < WS_END) { fprintf(stderr, "kernel_launch: unexpected shapes (n_in %d out %d ws %zu)\n", n_in, out_size, ws_size); grid = -1; return; }
        int dev = 0, cus = 0, per_cu = 0;
        hipGetDevice(&dev); hipDeviceGetAttribute(&cus, hipDeviceAttributeMultiprocessorCount, dev);
        hipFuncSetAttribute((const void*)mk_fwd, hipFuncAttributeMaxDynamicSharedMemorySize, LDS_BYTES);
        hipOccupancyMaxActiveBlocksPerMultiprocessor(&per_cu, (const void*)mk_fwd, NWAVES * 64, LDS_BYTES);
        if (per_cu < 1) { fprintf(stderr, "kernel_launch: occupancy query says %d blocks per CU\n", per_cu); per_cu = 1; }
        (void)hipGetLastError();
        grid = cus * per_cu;
        if (grid > 256) grid = 256;
    }
    if (grid < 0) return;
    Args a{};
    for (int i = 0; i < 18; ++i) a.in[i] = (const float*)d_in[i];
    a.out = (float*)d_out; a.ws = (unsigned char*)d_ws;
    (void)hipMemsetAsync((char*)d_ws + WS_CTL, 0, 16384 + 128 * 256 + 8192, stream);
#if MK_N_LAUNCHES == 1
    a.ph_lo = 0; a.ph_hi = NPHASE;
    void* kargs[] = {&a};
    hipError_t e = hipLaunchCooperativeKernel((const void*)mk_fwd, dim3(grid), dim3(NWAVES * 64), kargs, LDS_BYTES, stream);
    if (e != hipSuccess) fprintf(stderr, "cooperative launch failed: %s (grid %d)\n", hipGetErrorString(e), grid);
#else
    for (int ph = 0; ph < NPHASE; ++ph) { a.ph_lo = ph; a.ph_hi = ph + 1; hipLaunchKernelGGL(mk_fwd, dim3(grid), dim3(NWAVES * 64), LDS_BYTES, stream, a); }
#endif
}
```
